# Optimizing an MI355X kernel written in HIP

```python
import math
import jax, jax.numpy as jnp
from jax import lax
import numpy as np

D_MODEL = 1024
BATCH = 8
SEQ = 2048
DEPTH = 1

GRID_W = 64
CTX_LEN = 256
MIX_WIDTH = D_MODEL
RET_WIDTH = MIX_WIDTH // 2
RET_HEADS = 4
RET_HEAD_DIM = RET_WIDTH // RET_HEADS
RET_CHUNK = 128
SSM_WIDTH = MIX_WIDTH - RET_WIDTH
SSM_GROUP = 16
SSM_GROUPS = SSM_WIDTH // SSM_GROUP
SSM_STATE = 64
IN_WIDTH = 4 * RET_WIDTH + SSM_WIDTH
FFN_HIDDEN = -(-8 * D_MODEL // (3 * 256)) * 256
ROPE_BASE = 10000.0
NORM_EPS = 1e-6
DT_MIN = 1e-3
DT_MAX = 1e-1

kernel_name = 'hymba_retention_s5_prefix_dit_block'


def rms_norm(x, g):
    xf = x.astype(jnp.float32)
    y = xf * lax.rsqrt(jnp.mean(xf * xf, axis=-1, keepdims=True) + NORM_EPS)
    return (y * g.astype(jnp.float32)).astype(x.dtype)


def ada_mod(cvec, w_mod, b_mod):
    m = jax.nn.silu(cvec) @ w_mod + b_mod
    return jnp.split(m, 6, axis=-1)


def to_heads(t):
    b, l, _ = t.shape
    return t.reshape(b, l, RET_HEADS, RET_HEAD_DIM).transpose(0, 2, 1, 3)


def grid_rope(t):
    l, dh = t.shape[2], t.shape[3]
    n_rows = l // GRID_W
    rows = jnp.repeat(jnp.arange(n_rows, dtype=jnp.float32), GRID_W)
    cols = jnp.tile(jnp.arange(GRID_W, dtype=jnp.float32), n_rows)
    n_freq = dh // 4
    inv = ROPE_BASE ** (-jnp.arange(n_freq, dtype=jnp.float32) / n_freq)
    ang = jnp.concatenate([rows[:, None] * inv, cols[:, None] * inv], axis=-1)
    cos, sin = jnp.cos(ang), jnp.sin(ang)
    tp = t.reshape(*t.shape[:-1], dh // 2, 2)
    t0, t1 = tp[..., 0], tp[..., 1]
    out = jnp.stack([t0 * cos - t1 * sin, t0 * sin + t1 * cos], axis=-1)
    return out.reshape(t.shape)


def retention_states(k, v, lgf, lgb, init_f, init_b):
    b, h, l, dh = k.shape
    n = l // RET_CHUNK
    kc = k.reshape(b, h, n, RET_CHUNK, dh)
    vc = v.reshape(b, h, n, RET_CHUNK, dh)
    j = jnp.arange(RET_CHUNK, dtype=jnp.float32)
    wf = jnp.exp(lgf[:, None] * (RET_CHUNK - 1.0 - j))
    wb = jnp.exp(lgb[:, None] * j)
    kv_f = jnp.einsum('bhncd,hc,bhnce->nbhde', kc, wf, vc)
    kv_b = jnp.einsum('bhncd,hc,bhnce->nbhde', kc, wb, vc)
    df = jnp.exp(lgf * RET_CHUNK)[:, None, None]
    db = jnp.exp(lgb * RET_CHUNK)[:, None, None]

    def step_f(s, kv):
        return df * s + kv, s

    def step_b(s, kv):
        return kv + db * s, s

    fin_f, s_f = lax.scan(step_f, init_f, kv_f)
    fin_b, s_b = lax.scan(step_b, init_b, kv_b, reverse=True)
    return s_f, s_b, fin_f, fin_b


def retention_readout(q, k, v, g, lgf, lgb, s_f, s_b, gn):
    b, h, l, dh = q.shape
    n = l // RET_CHUNK
    qc = q.reshape(b, h, n, RET_CHUNK, dh)
    kc = k.reshape(b, h, n, RET_CHUNK, dh)
    vc = v.reshape(b, h, n, RET_CHUNK, dh)
    j = jnp.arange(RET_CHUNK, dtype=jnp.float32)
    diff = j[:, None] - j[None, :]
    lg_sel = jnp.where(diff[None] >= 0, lgf[:, None, None], lgb[:, None, None])
    mask = jnp.exp(lg_sel * jnp.abs(diff)[None])
    scores = jnp.einsum('bhnid,bhnjd->bhnij', qc, kc) * mask[:, None]
    intra = jnp.einsum('bhnij,bhnje->bhnie', scores, vc)
    qf = qc * jnp.exp(lgf[:, None] * (j + 1.0))[:, None, :, None]
    qb = qc * jnp.exp(lgb[:, None] * (RET_CHUNK - j))[:, None, :, None]
    inter = jnp.einsum('bhnid,nbhde->bhnie', qf, s_f) + jnp.einsum('bhnid,nbhde->bhnie', qb, s_b)
    o = (intra + inter).reshape(b, h, l, dh)
    mu = jnp.mean(o, axis=-1, keepdims=True)
    var = jnp.mean(jnp.square(o - mu), axis=-1, keepdims=True)
    o = (o - mu) * lax.rsqrt(var + NORM_EPS)
    o = o.transpose(0, 2, 1, 3).reshape(b, l, RET_WIDTH) * gn.astype(jnp.float32)
    return jax.nn.silu(g) * o


def complex_affine_combine(e1, e2):
    a1r, a1i, b1r, b1i = e1
    a2r, a2i, b2r, b2i = e2
    ar = a1r * a2r - a1i * a2i
    ai = a1r * a2i + a1i * a2r
    br = a2r * b1r - a2i * b1i + b2r
    bi = a2r * b1i + a2i * b1r + b2i
    return ar, ai, br, bi


def s5_scan(u_t, lam_re, lam_im, log_dt, b_re, b_im, h0_re, h0_im):
    f32 = jnp.float32
    lam_re, lam_im = lam_re.astype(f32), lam_im.astype(f32)
    b_re, b_im = b_re.astype(f32), b_im.astype(f32)
    dt = jnp.exp(log_dt.astype(f32))[:, None]
    mag = jnp.exp(dt * lam_re)
    a_re = mag * jnp.cos(dt * lam_im)
    a_im = mag * jnp.sin(dt * lam_im)
    den = lam_re * lam_re + lam_im * lam_im
    zr = ((a_re - 1.0) * lam_re + a_im * lam_im) / den
    zi = (a_im * lam_re - (a_re - 1.0) * lam_im) / den
    bb_re = zr[..., None] * b_re - zi[..., None] * b_im
    bb_im = zr[..., None] * b_im + zi[..., None] * b_re
    bu_re = jnp.einsum('lbgc,gnc->lbgn', u_t, bb_re)
    bu_im = jnp.einsum('lbgc,gnc->lbgn', u_t, bb_im)
    bu_re = bu_re.at[0].add(a_re * h0_re - a_im * h0_im)
    bu_im = bu_im.at[0].add(a_re * h0_im + a_im * h0_re)
    l = u_t.shape[0]
    a_re_t = jnp.broadcast_to(a_re, (l, 1) + a_re.shape)
    a_im_t = jnp.broadcast_to(a_im, (l, 1) + a_im.shape)
    _, _, x_re, x_im = lax.associative_scan(complex_affine_combine, (a_re_t, a_im_t, bu_re, bu_im), axis=0)
    return x_re, x_im


def s5_readout(u_t, xf_re, xf_im, xb_re, xb_im, c_re_f, c_im_f, c_re_b, c_im_b, d, w_glu, b_glu):
    f32 = jnp.float32
    yf = jnp.einsum('lbgn,gcn->lbgc', xf_re, c_re_f.astype(f32)) - jnp.einsum('lbgn,gcn->lbgc', xf_im, c_im_f.astype(f32))
    yb = jnp.einsum('lbgn,gcn->lbgc', xb_re, c_re_b.astype(f32)) - jnp.einsum('lbgn,gcn->lbgc', xb_im, c_im_b.astype(f32))
    y = yf + yb[::-1] + d.astype(f32).reshape(SSM_GROUPS, SSM_GROUP) * u_t
    l, b = u_t.shape[0], u_t.shape[1]
    y = y.reshape(l, b, SSM_WIDTH).transpose(1, 0, 2)
    z = jax.nn.gelu(y)
    return z * jax.nn.sigmoid(z @ w_glu.astype(f32) + b_glu.astype(f32))


def time_major_groups(u):
    b, l, _ = u.shape
    return u.transpose(1, 0, 2).reshape(l, b, SSM_GROUPS, SSM_GROUP)


def hybrid_mixer(h_lat, h_ctx, p, want_ctx_out):
    f32 = jnp.float32
    cuts = [RET_WIDTH, 2 * RET_WIDTH, 3 * RET_WIDTH, 4 * RET_WIDTH]
    q_l, k_l, v_l, g_l, u_l = jnp.split((h_lat @ p['w_in']).astype(f32), cuts, axis=-1)
    q_c, k_c, v_c, g_c, u_c = jnp.split((h_ctx @ p['w_in']).astype(f32), cuts, axis=-1)
    bsz = h_ctx.shape[0]
    lgf = -jnp.exp(p['ret_decay_f'].astype(f32))
    lgb = -jnp.exp(p['ret_decay_b'].astype(f32))
    k_scale = RET_HEAD_DIM ** -0.5

    kh_c = to_heads(k_c) * k_scale
    vh_c = to_heads(v_c)
    zero_ret = jnp.zeros((bsz, RET_HEADS, RET_HEAD_DIM, RET_HEAD_DIM), f32)
    sf_c, sb_c, fin_f, fin_b = retention_states(kh_c, vh_c, lgf, lgb, zero_ret, zero_ret)
    qh_l = grid_rope(to_heads(q_l))
    kh_l = grid_rope(to_heads(k_l)) * k_scale
    vh_l = to_heads(v_l)
    sf_l, sb_l, _, _ = retention_states(kh_l, vh_l, lgf, lgb, fin_f, fin_b)
    ret_l = retention_readout(qh_l, kh_l, vh_l, g_l, lgf, lgb, sf_l, sb_l, p['ret_gn'])

    fwd = (p['s5_lam_re_f'], p['s5_lam_im_f'], p['s5_log_dt_f'], p['s5_b_re_f'], p['s5_b_im_f'])
    bwd = (p['s5_lam_re_b'], p['s5_lam_im_b'], p['s5_log_dt_b'], p['s5_b_re_b'], p['s5_b_im_b'])
    readout_params = (p['s5_c_re_f'], p['s5_c_im_f'], p['s5_c_re_b'], p['s5_c_im_b'], p['s5_d'], p['w_glu'], p['b_glu'])
    zero_ssm = jnp.zeros((bsz, SSM_GROUPS, SSM_STATE), f32)
    u_ct = time_major_groups(u_c)
    cf_re, cf_im = s5_scan(u_ct, *fwd, zero_ssm, zero_ssm)
    cb_re, cb_im = s5_scan(u_ct[::-1], *bwd, zero_ssm, zero_ssm)
    u_lt = time_major_groups(u_l)
    lf_re, lf_im = s5_scan(u_lt, *fwd, cf_re[-1], cf_im[-1])
    lb_re, lb_im = s5_scan(u_lt[::-1], *bwd, cb_re[-1], cb_im[-1])
    s5_l = s5_readout(u_lt, lf_re, lf_im, lb_re, lb_im, *readout_params)

    mix_lat = jnp.concatenate([ret_l, s5_l], axis=-1).astype(h_lat.dtype)
    mix_ctx = None
    if want_ctx_out:
        qh_c = to_heads(q_c)
        ret_c = retention_readout(qh_c, kh_c, vh_c, g_c, lgf, lgb, sf_c, sb_c, p['ret_gn'])
        s5_c = s5_readout(u_ct, cf_re, cf_im, cb_re, cb_im, *readout_params)
        mix_ctx = jnp.concatenate([ret_c, s5_c], axis=-1).astype(h_ctx.dtype)
    return mix_lat, mix_ctx


def swiglu(h, w_in, w_out):
    gate, up = jnp.split(h @ w_in, 2, axis=-1)
    return (jax.nn.silu(gate) * up) @ w_out


def hybrid_layer(x, ctx, c, c_ctx, p, update_ctx):
    sh1, sc1, gt1, sh2, sc2, gt2 = [m[:, None, :] for m in ada_mod(c, p['w_mod'], p['b_mod'])]
    csh1, csc1, cgt1, csh2, csc2, cgt2 = ada_mod(c_ctx, p['w_mod'], p['b_mod'])
    h_lat = rms_norm(x, p['g_pre_mix']) * (1.0 + sc1) + sh1
    h_ctx = rms_norm(ctx, p['g_pre_mix']) * (1.0 + csc1) + csh1
    mix_lat, mix_ctx = hybrid_mixer(h_lat, h_ctx, p, update_ctx)
    x = x + gt1 * rms_norm(mix_lat @ p['w_out'], p['g_post_mix'])
    h = rms_norm(x, p['g_pre_ffn']) * (1.0 + sc2) + sh2
    x = x + gt2 * rms_norm(swiglu(h, p['w_ffn_in'], p['w_ffn_out']), p['g_post_ffn'])
    if update_ctx:
        ctx = ctx + cgt1 * rms_norm(mix_ctx @ p['w_out'], p['g_post_mix'])
        hc = rms_norm(ctx, p['g_pre_ffn']) * (1.0 + csc2) + csh2
        ctx = ctx + cgt2 * rms_norm(swiglu(hc, p['w_ffn_in'], p['w_ffn_out']), p['g_post_ffn'])
    return x, ctx


def setup_inputs(seed: int = 0) -> dict:
    key = jax.random.key(seed)
    ks = iter(jax.random.split(key, 64))
    f32 = jnp.float32
    D = D_MODEL
    G, N, CG = SSM_GROUPS, SSM_STATE, SSM_GROUP

    def nrm(shape, scale):
        return scale * jax.random.normal(next(ks), shape, f32)

    def gain(shape):
        return 1.0 + nrm(shape, 0.05)

    inp = {}
    inp['x'] = nrm((BATCH, SEQ, D), 1.0)
    inp['c'] = nrm((BATCH, D), 1.0)
    inp['ctx'] = nrm((BATCH, CTX_LEN, D), 1.0)
    inp['c_ctx'] = nrm((D,), 1.0)
    inp['w_mod'] = nrm((DEPTH, D, 6 * D), 0.5 * D ** -0.5)
    inp['b_mod'] = nrm((DEPTH, 6 * D), 0.01)
    inp['g_pre_mix'] = gain((DEPTH, D))
    inp['g_post_mix'] = gain((DEPTH, D))
    inp['w_in'] = nrm((DEPTH, D, IN_WIDTH), D ** -0.5)
    base = jnp.log(-jnp.log(1.0 - 2.0 ** (-5.0 - jnp.arange(RET_HEADS, dtype=f32))))
    inp['ret_decay_f'] = base + nrm((DEPTH, RET_HEADS), 0.01)
    inp['ret_decay_b'] = base + nrm((DEPTH, RET_HEADS), 0.01)
    inp['ret_gn'] = gain((DEPTH, RET_WIDTH))
    for sfx in ('f', 'b'):
        inp['s5_lam_re_' + sfx] = -0.5 + nrm((DEPTH, G, N), 0.01)
        inp['s5_lam_im_' + sfx] = math.pi * jnp.arange(N, dtype=f32) + nrm((DEPTH, G, N), 0.01)
        inp['s5_log_dt_' + sfx] = jax.random.uniform(next(ks), (DEPTH, G), dtype=f32, minval=math.log(DT_MIN), maxval=math.log(DT_MAX))
        inp['s5_b_re_' + sfx] = nrm((DEPTH, G, N, CG), (2 * CG) ** -0.5)
        inp['s5_b_im_' + sfx] = nrm((DEPTH, G, N, CG), (2 * CG) ** -0.5)
        inp['s5_c_re_' + sfx] = nrm((DEPTH, G, CG, N), N ** -0.5)
        inp['s5_c_im_' + sfx] = nrm((DEPTH, G, CG, N), N ** -0.5)
    inp['s5_d'] = nrm((DEPTH, SSM_WIDTH), 0.5)
    inp['w_glu'] = nrm((DEPTH, SSM_WIDTH, SSM_WIDTH), SSM_WIDTH ** -0.5)
    inp['b_glu'] = nrm((DEPTH, SSM_WIDTH), 0.01)
    inp['w_out'] = nrm((DEPTH, MIX_WIDTH, D), MIX_WIDTH ** -0.5)
    inp['g_pre_ffn'] = gain((DEPTH, D))
    inp['g_post_ffn'] = gain((DEPTH, D))
    inp['w_ffn_in'] = nrm((DEPTH, D, 2 * FFN_HIDDEN), D ** -0.5)
    inp['w_ffn_out'] = nrm((DEPTH, FFN_HIDDEN, D), FFN_HIDDEN ** -0.5)
    return inp


def reference(x, c, ctx, c_ctx, w_mod, b_mod, g_pre_mix, g_post_mix, w_in, ret_decay_f, ret_decay_b, ret_gn,
              s5_lam_re_f, s5_lam_im_f, s5_log_dt_f, s5_b_re_f, s5_b_im_f, s5_c_re_f, s5_c_im_f,
              s5_lam_re_b, s5_lam_im_b, s5_log_dt_b, s5_b_re_b, s5_b_im_b, s5_c_re_b, s5_c_im_b,
              s5_d, w_glu, b_glu, w_out, g_pre_ffn, g_post_ffn, w_ffn_in, w_ffn_out):
    for layer in range(DEPTH):
        p = {
            'w_mod': w_mod[layer], 'b_mod': b_mod[layer],
            'g_pre_mix': g_pre_mix[layer], 'g_post_mix': g_post_mix[layer],
            'w_in': w_in[layer], 'ret_decay_f': ret_decay_f[layer], 'ret_decay_b': ret_decay_b[layer],
            'ret_gn': ret_gn[layer],
            's5_lam_re_f': s5_lam_re_f[layer], 's5_lam_im_f': s5_lam_im_f[layer], 's5_log_dt_f': s5_log_dt_f[layer],
            's5_b_re_f': s5_b_re_f[layer], 's5_b_im_f': s5_b_im_f[layer],
            's5_c_re_f': s5_c_re_f[layer], 's5_c_im_f': s5_c_im_f[layer],
            's5_lam_re_b': s5_lam_re_b[layer], 's5_lam_im_b': s5_lam_im_b[layer], 's5_log_dt_b': s5_log_dt_b[layer],
            's5_b_re_b': s5_b_re_b[layer], 's5_b_im_b': s5_b_im_b[layer],
            's5_c_re_b': s5_c_re_b[layer], 's5_c_im_b': s5_c_im_b[layer],
            's5_d': s5_d[layer], 'w_glu': w_glu[layer], 'b_glu': b_glu[layer],
            'w_out': w_out[layer], 'g_pre_ffn': g_pre_ffn[layer], 'g_post_ffn': g_post_ffn[layer],
            'w_ffn_in': w_ffn_in[layer], 'w_ffn_out': w_ffn_out[layer],
        }
        x, ctx = hybrid_layer(x, ctx, c, c_ctx, p, layer < DEPTH - 1)
    return x
```

```cpp
#include <hip/hip_runtime.h>
#include <hip/hip_cooperative_groups.h>
#include <cstdio>
#include <cstdint>
namespace cg = cooperative_groups;

typedef unsigned short bf16_t;
__device__ __forceinline__ float bf2f(bf16_t v) { return __uint_as_float(((unsigned)v) << 16); }
__device__ __forceinline__ bf16_t f2bf(float f) { unsigned u = __float_as_uint(f); u += 0x7fffu + ((u >> 16) & 1u); return (bf16_t)(u >> 16); }

constexpr int D = 1024, BATCH = 8, SEQ = 2048, CTX = 256;
constexpr int ML = BATCH * SEQ;
constexpr int MC = BATCH * CTX;
constexpr int MT = ML + MC;
constexpr int RW = 512, NH = 4, DH = 128;
constexpr int SW = 512, SG = 16, NG = 32, SN = 64;
constexpr int INW = 2560, FH = 2816;
constexpr int TCH = 32;
constexpr float EPS = 1e-6f;
constexpr float KSCALE = 0.08838834764831845f;

constexpr size_t MiB = 1u << 20;
constexpr size_t WS_CTL = 0, CTL_ZERO_BYTES = 1 * MiB;
constexpr size_t WS_MOD = 64 * 1024;
constexpr size_t WS_ROPE = 1 * MiB;
constexpr size_t WS_WIN = 2 * MiB;
constexpr size_t WS_WGLU = 7 * MiB;
constexpr size_t WS_WOUT = 8 * MiB;
constexpr size_t WS_WFI = 10 * MiB;
constexpr size_t WS_WFO = 21 * MiB;
constexpr size_t WS_BTE = 27 * MiB;
constexpr size_t WS_BTY = 35 * MiB;
constexpr size_t WS_H = 59 * MiB;
constexpr size_t WS_QKVG = 95 * MiB;
constexpr size_t WS_UA = 167 * MiB;
constexpr size_t WS_E = 203 * MiB;
constexpr size_t WS_KC = 228 * MiB;
constexpr size_t WS_AT = 231 * MiB;
constexpr size_t WS_Z = 235 * MiB;
constexpr size_t WS_Y1 = 95 * MiB;
constexpr size_t WS_HID = 95 * MiB;
constexpr size_t WS_Y2 = 27 * MiB;

enum { I_X = 0, I_C, I_CTX, I_CCTX, I_WMOD, I_BMOD, I_GPREMIX, I_GPOSTMIX, I_WIN, I_DECF, I_DECB, I_GN,
       I_LRF, I_LIF, I_LDTF, I_BRF, I_BIF, I_CRF, I_CIF,
       I_LRB, I_LIB, I_LDTB, I_BRB, I_BIB, I_CRB, I_CIB,
       I_S5D, I_WGLU, I_BGLU, I_WOUT, I_GPREFFN, I_GPOSTFFN, I_WFFNIN, I_WFFNOUT, N_IN };

__device__ __forceinline__ float silu_f(float v) { return v / (1.0f + expf(-v)); }
__device__ __forceinline__ float sigmoid_f(float v) { return 1.0f / (1.0f + expf(-v)); }
__device__ __forceinline__ float gelu_tanh_f(float v) { const float u = 0.7978845608028654f * (v + 0.044715f * v * v * v); return 0.5f * v * (1.0f + tanhf(u)); }
__device__ __forceinline__ float fsigmoid(float v) { return __builtin_amdgcn_rcpf(1.0f + __builtin_amdgcn_exp2f(-1.4426950408889634f * v)); }
__device__ __forceinline__ float fsilu(float v) { return v * fsigmoid(v); }
__device__ __forceinline__ float fgelu_tanh(float v) { const float u = 0.7978845608028654f * (v + 0.044715f * v * v * v); return v * fsigmoid(2.0f * u); }
__device__ __forceinline__ float wave_sum(float v) {
#pragma unroll
    for (int o = 1; o < 64; o <<= 1) v += __shfl_xor(v, o);
    return v;
}

namespace pg8 {
#define PG8_LAS __attribute__((address_space(3)))
typedef short bf16x8 __attribute__((ext_vector_type(8)));
typedef float f32x4 __attribute__((ext_vector_type(4)));
typedef unsigned u32x4 __attribute__((ext_vector_type(4)));
constexpr int BM = 256, BK = 64, HALF = 128, HTB = HALF * BK * 2  , STAGE_BYTES = 8 * HTB, NXCD = 8, WGM = 8;

__host__ __device__ __forceinline__ int lds_byte(int r, int c) { const int st = (r >> 4) * 2 + (c >> 5), rr = r & 15, cc = c & 31, ob = rr * 64 + cc * 2; return st * 1024 + (ob ^ (((ob >> 9) & 1) << 5)); }
__host__ __device__ __forceinline__ void stage_rc(int b, int& R, int& C) { const int st = b / 1024, sb = b % 1024, swz = sb ^ (((sb >> 9) & 1) << 5); R = (st >> 1) * 16 + swz / 64; C = (st & 1) * 32 + (swz % 64) / 2; }
__host__ __device__ __forceinline__ int perm32(int rho) { const int n = rho >> 4, i = rho & 15; return 8 * (i >> 2) + 4 * n + (i & 3); }

struct Unit { int pm, pn; };
struct Gemm { const bf16_t* A; const bf16_t* Bt; int lda, ldb, K; };

struct StaticOrder {
    int nM, nN, nwg, G, c;
    __device__ void init(int nM_, int nN_, int G_, int c_) { nM = nM_; nN = nN_; nwg = nM * nN; G = G_; c = c_; }
    __device__ bool next(int i, Unit& u) const {
        const long L = (long)i * G + c; if (L >= nwg) return false;
        int wgid = (int)L; { const int q = nwg / NXCD, r = nwg % NXCD, xcd = wgid % NXCD, off = wgid / NXCD; wgid = (xcd < r ? xcd * (q + 1) : r * (q + 1) + (xcd - r) * q) + off; }
        const int nig = WGM * nN, gid = wgid / nig, fm = gid * WGM, gsz = (nM - fm) < WGM ? (nM - fm) : WGM;
        u.pm = fm + ((wgid % nig) % gsz); u.pn = (wgid % nig) / gsz; return true;
    }
    __device__ __forceinline__ void a_ready(const Unit&) const {}
    __device__ __forceinline__ void done(const Unit&) const {}
};
struct S5EOrder {
    int G, c;
    __device__ bool next(int i, Unit& u) const { const int L = i * G + c; if (L >= 96) return false; u.pm = L; u.pn = L / 3; return true; }
    __device__ __forceinline__ void a_ready(const Unit&) const {}
    __device__ __forceinline__ void done(const Unit&) const {}
};
struct S5YOrder {
    int G, c;
    __device__ bool next(int i, Unit& u) const { const int L = i * G + c; if (L >= 128) return false; const int g = L >> 2; u.pm = 3 * g + ((L >> 1) & 1); u.pn = 2 * g + (L & 1); return true; }
    __device__ __forceinline__ void a_ready(const Unit&) const {}
    __device__ __forceinline__ void done(const Unit&) const {}
};

typedef __bf16 bf16x2_t __attribute__((ext_vector_type(2)));
typedef float f32x2_t __attribute__((ext_vector_type(2)));
__device__ __forceinline__ unsigned cvt_pk_bf16(float lo, float hi) { const f32x2_t v = {lo, hi}; return __builtin_bit_cast(unsigned, __builtin_convertvector(v, bf16x2_t)); }
__device__ __forceinline__ u32x4 pack8(const f32x4 v0, const f32x4 v1) { u32x4 w; w.x = cvt_pk_bf16(v0[0], v0[1]); w.y = cvt_pk_bf16(v0[2], v0[3]); w.z = cvt_pk_bf16(v1[0], v1[1]); w.w = cvt_pk_bf16(v1[2], v1[3]); return w; }
__device__ __forceinline__ float bflo(unsigned w) { return __uint_as_float(w << 16); }
__device__ __forceinline__ float bfhi(unsigned w) { return __uint_as_float(w & 0xffff0000u); }

struct EpiInProjM {
    static constexpr bool PERM = true, AFTER_DRAIN = false;
    bf16_t* QKVG; bf16_t* UA; const float* ROPE;
    __device__ __forceinline__ void operator()(const f32x4 (&acc)[2][2][4][2], const Unit& u, int wr, int wc, int fr, int fq) const {
        const int row0 = u.pm * BM + wr * 64 + fr; const int kind = u.pn >> 1; const bool lat = u.pm < 64;
#pragma unroll
        for (int ai = 0; ai < 2; ++ai)
#pragma unroll
            for (int m = 0; m < 4; ++m) {
                const int r = row0 + ai * HALF + m * 16;
                const int b = lat ? (r >> 11) : ((r - ML) >> 8); const int l = lat ? (r & 2047) : ((r - ML) & 255);
#pragma unroll
                for (int bj = 0; bj < 2; ++bj) {
                    const int c0 = u.pn * BM + bj * HALF + wc * 32 + 8 * fq;
                    f32x4 v0 = acc[ai][bj][m][0], v1 = acc[ai][bj][m][1];
                    if (kind <= 1) {
                        if (lat) {
                            const int p0 = 16 * wc + 4 * fq; const int pos = (wc < 2) ? (l >> 6) : (l & 63); const int f0 = p0 & 31;
                            const f32x4* rp = (const f32x4*)(ROPE + (size_t)(pos * 32 + f0) * 2);
                            const f32x4 cs01 = rp[0], cs23 = rp[1];
                            f32x4 t0, t1;
                            t0[0] = v0[0] * cs01[0] - v0[1] * cs01[1]; t0[1] = v0[0] * cs01[1] + v0[1] * cs01[0];
                            t0[2] = v0[2] * cs01[2] - v0[3] * cs01[3]; t0[3] = v0[2] * cs01[3] + v0[3] * cs01[2];
                            t1[0] = v1[0] * cs23[0] - v1[1] * cs23[1]; t1[1] = v1[0] * cs23[1] + v1[1] * cs23[0];
                            t1[2] = v1[2] * cs23[2] - v1[3] * cs23[3]; t1[3] = v1[2] * cs23[3] + v1[3] * cs23[2];
                            v0 = t0; v1 = t1;
                        }
                        if (kind == 1) { v0 = v0 * KSCALE; v1 = v1 * KSCALE; }
                    }
                    const u32x4 w = pack8(v0, v1);
                    if (kind < 4) *(u32x4*)(QKVG + (size_t)r * 2048 + c0) = w;
                    else { const int cu = c0 - 2048, g = cu >> 4, cc = cu & 15, chunk = l >> 5, jj = l & 31; const int rowA = lat ? b * 64 + chunk : 512 + b * 8 + chunk;
                        *(u32x4*)(UA + ((size_t)g * 768 + rowA) * 768 + jj * 16 + cc) = w; }
                }
            }
    }
};
struct EpiGluM {
    static constexpr bool PERM = true, AFTER_DRAIN = false;
    const bf16_t* Z; const float* bglu; bf16_t* MIX;
    __device__ __forceinline__ void operator()(const f32x4 (&acc)[2][2][4][2], const Unit& u, int wr, int wc, int fr, int fq) const {
        const int row0 = u.pm * BM + wr * 64 + fr;
#pragma unroll
        for (int bj = 0; bj < 2; ++bj) {
            const int c0 = u.pn * BM + bj * HALF + wc * 32 + 8 * fq;
            const f32x4 b0 = *(const f32x4*)(bglu + c0), b1 = *(const f32x4*)(bglu + c0 + 4);
#pragma unroll
            for (int ai = 0; ai < 2; ++ai)
#pragma unroll
                for (int m = 0; m < 4; ++m) {
                    const int r = row0 + ai * HALF + m * 16;
                    const u32x4 zz = *(const u32x4*)(Z + (size_t)r * SW + c0);
                    const f32x4 a0 = acc[ai][bj][m][0] + b0, a1 = acc[ai][bj][m][1] + b1;
                    f32x4 o0, o1;
                    o0[0] = bflo(zz.x) * fsigmoid(a0[0]); o0[1] = bfhi(zz.x) * fsigmoid(a0[1]); o0[2] = bflo(zz.y) * fsigmoid(a0[2]); o0[3] = bfhi(zz.y) * fsigmoid(a0[3]);
                    o1[0] = bflo(zz.z) * fsigmoid(a1[0]); o1[1] = bfhi(zz.z) * fsigmoid(a1[1]); o1[2] = bflo(zz.w) * fsigmoid(a1[2]); o1[3] = bfhi(zz.w) * fsigmoid(a1[3]);
                    *(u32x4*)(MIX + (size_t)r * D + 512 + c0) = pack8(o0, o1);
                }
        }
    }
};
struct EpiF32M {
    static constexpr bool PERM = false, AFTER_DRAIN = false;
    float* C; int ldc;
    __device__ __forceinline__ void operator()(const f32x4 (&acc)[2][2][4][2], const Unit& u, int wr, int wc, int fr, int fq) const {
        const int row0 = u.pm * BM + wr * 64 + fr, col0 = u.pn * BM + wc * 32 + 4 * fq;
#pragma unroll
        for (int ai = 0; ai < 2; ++ai)
#pragma unroll
            for (int m = 0; m < 4; ++m) { float* rowp = C + (size_t)(row0 + ai * HALF + m * 16) * ldc + col0;
#pragma unroll
                for (int bj = 0; bj < 2; ++bj)
#pragma unroll
                    for (int n = 0; n < 2; ++n) *(f32x4*)(rowp + bj * HALF + n * 16) = acc[ai][bj][m][n]; }
    }
};
struct EpiSwigluM {
    static constexpr bool PERM = true, AFTER_DRAIN = false;
    bf16_t* HID;
    __device__ __forceinline__ void operator()(const f32x4 (&acc)[2][2][4][2], const Unit& u, int wr, int wc, int fr, int fq) const {
        const int row0 = u.pm * BM + wr * 64 + fr, c0 = u.pn * HALF + wc * 32 + 8 * fq;
#pragma unroll
        for (int ai = 0; ai < 2; ++ai)
#pragma unroll
            for (int m = 0; m < 4; ++m) {
                const int r = row0 + ai * HALF + m * 16;
                f32x4 o[2];
#pragma unroll
                for (int n = 0; n < 2; ++n) { const f32x4 gt = acc[ai][0][m][n], up = acc[ai][1][m][n];
#pragma unroll
                    for (int j = 0; j < 4; ++j) o[n][j] = fsilu(gt[j]) * up[j]; }
                *(u32x4*)(HID + (size_t)r * FH + c0) = pack8(o[0], o[1]);
            }
    }
};
struct EpiS5E {
    static constexpr bool PERM = false, AFTER_DRAIN = false;
    float* E;
    __device__ __forceinline__ void operator()(const f32x4 (&acc)[2][2][4][2], const Unit& u, int wr, int wc, int fr, int fq) const {
        const int g = u.pn; const int rl0 = (u.pm - 3 * g) * BM + wr * 64 + fr, col0 = wc * 32 + 4 * fq;
#pragma unroll
        for (int ai = 0; ai < 2; ++ai)
#pragma unroll
            for (int m = 0; m < 4; ++m) { float* rowp = E + ((size_t)g * 768 + rl0 + ai * HALF + m * 16) * 256 + col0;
#pragma unroll
                for (int bj = 0; bj < 2; ++bj)
#pragma unroll
                    for (int n = 0; n < 2; ++n) *(f32x4*)(rowp + bj * HALF + n * 16) = acc[ai][bj][m][n]; }
    }
};
struct EpiS5Y {
    static constexpr bool PERM = true, AFTER_DRAIN = false;
    bf16_t* Z;
    __device__ __forceinline__ void operator()(const f32x4 (&acc)[2][2][4][2], const Unit& u, int wr, int wc, int fr, int fq) const {
        const int g = u.pn >> 1; const int rl0 = (u.pm - 3 * g) * BM + wr * 64 + fr;
#pragma unroll
        for (int ai = 0; ai < 2; ++ai)
#pragma unroll
            for (int m = 0; m < 4; ++m) {
                const int rl = rl0 + ai * HALF + m * 16; const int b = rl >> 6, chunk = rl & 63;
#pragma unroll
                for (int bj = 0; bj < 2; ++bj) {
                    const int cl = (u.pn & 1) * BM + bj * HALF + wc * 32 + 8 * fq; const int i = cl >> 4, c0 = cl & 15;
                    const size_t tok = (size_t)b * SEQ + chunk * TCH + i;
                    f32x4 o0, o1;
#pragma unroll
                    for (int j = 0; j < 4; ++j) { o0[j] = fgelu_tanh(acc[ai][bj][m][0][j]); o1[j] = fgelu_tanh(acc[ai][bj][m][1][j]); }
                    *(u32x4*)(Z + tok * SW + g * 16 + c0) = pack8(o0, o1);
                }
            }
    }
};

template <class Epi, class Sched, bool ALIGN_EPI = false, bool SP2 = false>
__device__ __forceinline__ void gemm_phase(PG8_LAS unsigned char* lds, const Gemm g, const Sched& S, const Epi& E) {
    const int tid = threadIdx.x, wid = __builtin_amdgcn_readfirstlane(tid >> 6), lane = tid & 63, wr = wid >> 2, wc = wid & 3, fr = lane & 15, fq = lane >> 4;
    const int K = g.K, nt = K / BK;
    unsigned voffA[2], voffB[2];
#pragma unroll
    for (int i = 0; i < 2; ++i) { int R, C; stage_rc(tid * 16 + i * 8192, R, C); const int Rb = Epi::PERM ? ((R & ~31) + perm32(R & 31)) : R;
        voffA[i] = (unsigned)(R * g.lda + C) * 2u; voffB[i] = (unsigned)(Rb * g.ldb + C) * 2u; }
    const size_t kstep = (size_t)(BK * 2);
    const size_t hstepA = (size_t)HALF * g.lda * 2, hstepB = (size_t)HALF * g.ldb * 2;
    const size_t tstepA = 2 * hstepA, tstepB = 2 * hstepB;
    const unsigned ldsw = (unsigned)wid * 1024u;
    const int aoff = lds_byte(wr * 64 + fr, fq * 8), boff = lds_byte(wc * 32 + fr, fq * 8);
#define PG8_SA(b, h) (((b) * 2 + (h)) * HTB)
#define PG8_SB(b, h) ((4 + (b) * 2 + (h)) * HTB)
#define PG8_STAGE(bufoff, gbase, voff) do { _Pragma("unroll") for (int _i = 0; _i < 2; ++_i) \
        __builtin_amdgcn_global_load_lds((const unsigned*)((const char*)(gbase) + (voff)[_i]), (PG8_LAS unsigned*)(lds + (bufoff) + ldsw + _i * 8192), 16, 0, 0); } while (0)
#define PG8_LDA(dst, b, h) do { _Pragma("unroll") for (int m = 0; m < 4; ++m) _Pragma("unroll") for (int k = 0; k < 2; ++k) dst[m][k] = *(const PG8_LAS bf16x8*)(lds + PG8_SA(b, h) + aoff + m * 2048 + k * 1024); } while (0)
#define PG8_LDB(dst, b, h) do { _Pragma("unroll") for (int n = 0; n < 2; ++n) _Pragma("unroll") for (int k = 0; k < 2; ++k) dst[n][k] = *(const PG8_LAS bf16x8*)(lds + PG8_SB(b, h) + boff + n * 2048 + k * 1024); } while (0)
#define PG8_MMA(ai, bj, At, Bt) do { __builtin_amdgcn_s_setprio(1); _Pragma("unroll") for (int m = 0; m < 4; ++m) _Pragma("unroll") for (int n = 0; n < 2; ++n) _Pragma("unroll") for (int k = 0; k < 2; ++k) \
        acc[ai][bj][m][n] = __builtin_amdgcn_mfma_f32_16x16x32_bf16(Bt[n][k], At[m][k], acc[ai][bj][m][n], 0, 0, 0); __builtin_amdgcn_s_setprio(0); } while (0)
#define PG8_WAIT_V(n) asm volatile("s_waitcnt vmcnt(" #n ")" ::: "memory")
#define PG8_WAIT_L(n) asm volatile("s_waitcnt lgkmcnt(" #n ")" ::: "memory")
#define PG8_BAR __builtin_amdgcn_s_barrier()
#define PG8_SCHED __builtin_amdgcn_sched_barrier(0)
    Unit cur, nxt; int ui = 0;
    if (!S.next(0, cur)) return;
    f32x4 acc[2][2][4][2];
#pragma unroll
    for (int a = 0; a < 2; ++a)
#pragma unroll
        for (int b = 0; b < 2; ++b)
#pragma unroll
            for (int m = 0; m < 4; ++m)
#pragma unroll
                for (int n = 0; n < 2; ++n) acc[a][b][m][n] = (f32x4){0.f, 0.f, 0.f, 0.f};
    bf16x8 At[4][2], B0[2][2], B1[2][2];
    const char* cA = (const char*)g.A + (size_t)cur.pm * tstepA; const char* cB = (const char*)g.Bt + (size_t)cur.pn * tstepB;
    S.a_ready(cur);
    if constexpr (SP2) {
        PG8_STAGE(PG8_SB(0, 0), cB, voffB); PG8_STAGE(PG8_SB(0, 1), cB + hstepB, voffB); PG8_STAGE(PG8_SA(0, 0), cA, voffA); PG8_STAGE(PG8_SA(0, 1), cA + hstepA, voffA);
        if (wr == 1) PG8_BAR;
        PG8_WAIT_V(2); PG8_BAR;
        PG8_STAGE(PG8_SB(1, 0), cB + kstep, voffB); PG8_STAGE(PG8_SA(1, 0), cA + kstep, voffA); PG8_STAGE(PG8_SB(1, 1), cB + hstepB + kstep, voffB);
        PG8_WAIT_V(6); PG8_BAR;
    } else {
        PG8_STAGE(PG8_SB(0, 0), cB, voffB); PG8_STAGE(PG8_SA(0, 0), cA, voffA); PG8_STAGE(PG8_SB(0, 1), cB + hstepB, voffB); PG8_STAGE(PG8_SA(0, 1), cA + hstepA, voffA);
        if (wr == 1) PG8_BAR;
        PG8_WAIT_V(4); PG8_BAR;
        PG8_STAGE(PG8_SB(1, 0), cB + kstep, voffB); PG8_STAGE(PG8_SA(1, 0), cA + kstep, voffA); PG8_STAGE(PG8_SB(1, 1), cB + hstepB + kstep, voffB);
        PG8_WAIT_V(6); PG8_BAR;
    }
    for (;;) {
        const bool has_next = S.next(ui + 1, nxt);
        const char* nA = has_next ? (const char*)g.A + (size_t)nxt.pm * tstepA : cA; const char* nB = has_next ? (const char*)g.Bt + (size_t)nxt.pn * tstepB : cB;
        for (int t = 0; t < nt; t += 2) {
            const bool last = (t == nt - 2);
            const char* a1 = cA + (size_t)(t + 1) * kstep;
            const char* a2 = last ? nA : cA + (size_t)(t + 2) * kstep; const char* b2 = last ? nB : cB + (size_t)(t + 2) * kstep;
            const char* a3 = a2 + kstep; const char* b3 = b2 + kstep;
            if (last && has_next) S.a_ready(nxt);
            if constexpr (SP2) {
            PG8_LDB(B0, 0, 0); PG8_LDB(B1, 0, 1); PG8_SCHED; PG8_LDA(At, 0, 0); PG8_STAGE(PG8_SA(1, 1), a1 + hstepA, voffA);
            PG8_WAIT_V(8); PG8_WAIT_L(0); PG8_BAR; PG8_MMA(0, 0, At, B0); PG8_MMA(0, 1, At, B1); PG8_BAR; PG8_SCHED;
            PG8_LDA(At, 0, 1); PG8_STAGE(PG8_SB(0, 0), b2, voffB); PG8_STAGE(PG8_SB(0, 1), b2 + hstepB, voffB); PG8_STAGE(PG8_SA(0, 0), a2, voffA);
            PG8_WAIT_V(8); PG8_WAIT_L(0); PG8_BAR; PG8_MMA(1, 0, At, B0); PG8_MMA(1, 1, At, B1); PG8_BAR; PG8_SCHED;
            PG8_LDB(B0, 1, 0); PG8_LDB(B1, 1, 1); PG8_SCHED; PG8_LDA(At, 1, 0); PG8_STAGE(PG8_SA(0, 1), a2 + hstepA, voffA);
            PG8_WAIT_V(8); PG8_WAIT_L(0); PG8_BAR; PG8_MMA(0, 0, At, B0); PG8_MMA(0, 1, At, B1); PG8_BAR; PG8_SCHED;
            PG8_LDA(At, 1, 1); PG8_STAGE(PG8_SB(1, 0), b3, voffB); PG8_STAGE(PG8_SB(1, 1), b3 + hstepB, voffB); PG8_STAGE(PG8_SA(1, 0), a3, voffA);
            PG8_WAIT_V(8); PG8_WAIT_L(0); PG8_BAR; PG8_MMA(1, 0, At, B0); PG8_MMA(1, 1, At, B1); PG8_BAR; PG8_SCHED;
            } else {
            PG8_LDB(B0, 0, 0); PG8_SCHED; PG8_LDA(At, 0, 0); PG8_STAGE(PG8_SA(1, 1), a1 + hstepA, voffA);
            PG8_WAIT_L(8); PG8_BAR; PG8_WAIT_L(0); PG8_MMA(0, 0, At, B0); PG8_BAR; PG8_SCHED;
            PG8_LDB(B1, 0, 1); PG8_STAGE(PG8_SB(0, 0), b2, voffB);
            PG8_BAR; PG8_WAIT_L(0); PG8_MMA(0, 1, At, B1); PG8_BAR;
            PG8_LDA(At, 0, 1); PG8_STAGE(PG8_SA(0, 0), a2, voffA);
            PG8_BAR; PG8_WAIT_L(0); PG8_MMA(1, 0, At, B0); PG8_BAR; PG8_SCHED;
            PG8_STAGE(PG8_SB(0, 1), b2 + hstepB, voffB);
            PG8_WAIT_V(6); PG8_BAR; PG8_MMA(1, 1, At, B1); PG8_BAR;
            PG8_LDB(B0, 1, 0); PG8_SCHED; PG8_LDA(At, 1, 0); PG8_STAGE(PG8_SA(0, 1), a2 + hstepA, voffA);
            PG8_WAIT_L(8); PG8_BAR; PG8_WAIT_L(0); PG8_MMA(0, 0, At, B0); PG8_BAR; PG8_SCHED;
            PG8_LDB(B1, 1, 1); PG8_STAGE(PG8_SB(1, 0), b3, voffB);
            PG8_BAR; PG8_WAIT_L(0); PG8_MMA(0, 1, At, B1); PG8_BAR;
            PG8_LDA(At, 1, 1); PG8_STAGE(PG8_SA(1, 0), a3, voffA);
            PG8_BAR; PG8_WAIT_L(0); PG8_MMA(1, 0, At, B0); PG8_BAR; PG8_SCHED;
            PG8_STAGE(PG8_SB(1, 1), b3 + hstepB, voffB);
            PG8_WAIT_V(6); PG8_BAR; PG8_MMA(1, 1, At, B1); PG8_BAR;
            }
        }
        if constexpr (ALIGN_EPI) { if (wr == 0) PG8_BAR; }
        if constexpr (!Epi::AFTER_DRAIN) { E(acc, cur, wr, wc, fr, fq); S.done(cur); }
        if (!has_next) break;
#pragma unroll
        for (int a = 0; a < 2; ++a)
#pragma unroll
            for (int b = 0; b < 2; ++b)
#pragma unroll
                for (int m = 0; m < 4; ++m)
#pragma unroll
                    for (int n = 0; n < 2; ++n) acc[a][b][m][n] = (f32x4){0.f, 0.f, 0.f, 0.f};
        cur = nxt; cA = nA; cB = nB; ++ui;
        if constexpr (ALIGN_EPI) { if (wr == 1) PG8_BAR; }
    }
    PG8_WAIT_V(0);
    if constexpr (!ALIGN_EPI) { if (wr == 0) PG8_BAR; }
    PG8_BAR;
    if constexpr (Epi::AFTER_DRAIN) { E.fused(acc, cur, wr, wc, fr, fq, lds, wid, lane); S.done(cur); }
#undef PG8_SA
#undef PG8_SB
#undef PG8_STAGE
#undef PG8_LDA
#undef PG8_LDB
#undef PG8_MMA
#undef PG8_WAIT_V
#undef PG8_WAIT_L
#undef PG8_BAR
#undef PG8_SCHED
}
}

#define LAS __attribute__((address_space(3)))
constexpr int NWAVES = 8, NTHREADS = 512;
constexpr int LDS_BYTES = 147456;

struct Args { const float* in[N_IN]; float* out; unsigned char* ws; int ph_lo, ph_hi; };

__device__ __forceinline__ void transpose_item(const float* W, int N, bf16_t* WT, int ldt, int dst_row0, LAS float* scr, int k0, int n0, int lane) {
#pragma unroll 8
    for (int i = 0; i < 32; ++i) { const int kk = 2 * i + (lane >> 5); scr[kk * 33 + (lane & 31)] = W[(size_t)(k0 + kk) * N + n0 + (lane & 31)]; }
    asm volatile("s_waitcnt lgkmcnt(0)" ::: "memory");
    const int c = lane & 7;
#pragma unroll
    for (int j = 0; j < 4; ++j) { const int n = (lane >> 3) + 8 * j; const LAS float* s = scr + (8 * c) * 33 + n;
        pg8::u32x4 o; o.x = pg8::cvt_pk_bf16(s[0 * 33], s[1 * 33]); o.y = pg8::cvt_pk_bf16(s[2 * 33], s[3 * 33]); o.z = pg8::cvt_pk_bf16(s[4 * 33], s[5 * 33]); o.w = pg8::cvt_pk_bf16(s[6 * 33], s[7 * 33]);
        *(pg8::u32x4*)(WT + (size_t)(dst_row0 + n) * ldt + k0 + 8 * c) = o; }
    asm volatile("s_waitcnt lgkmcnt(0)" ::: "memory");
}


struct S5Par { const float *lr, *li, *ldt, *br, *bi, *cr, *ci; };
__device__ __forceinline__ void p0_s5_tables(const Args& a, LAS unsigned char* lds, int g, int dir, int tid) {
    const S5Par p = dir ? S5Par{a.in[I_LRB], a.in[I_LIB], a.in[I_LDTB], a.in[I_BRB], a.in[I_BIB], a.in[I_CRB], a.in[I_CIB]}
                        : S5Par{a.in[I_LRF], a.in[I_LIF], a.in[I_LDTF], a.in[I_BRF], a.in[I_BIF], a.in[I_CRF], a.in[I_CIF]};
    typedef float f32x2 __attribute__((ext_vector_type(2)));
    LAS f32x2* AP = (LAS f32x2*)lds;
    LAS f32x2* BB = (LAS f32x2*)(lds + 33 * 64 * 8);
    LAS f32x2* CC = (LAS f32x2*)(lds + 33 * 64 * 8 + 1024 * 8);
    const double dt = (double)expf(p.ldt[g]);
    for (int idx = tid; idx < 33 * 64; idx += NTHREADS) { const int t = idx >> 6, n = idx & 63;
        const double lr = (double)p.lr[g * SN + n], li = (double)p.li[g * SN + n];
        const double ang = (double)t * dt * li; const float rf = (float)(ang - rint(ang * 0.15915494309189535) * 6.283185307179586);
        const float mag = expf((float)((double)t * dt * lr));
        AP[idx] = (f32x2){mag * cosf(rf), mag * sinf(rf)}; }
    for (int idx = tid; idx < 64 * 16; idx += NTHREADS) { const int n = idx >> 4;
        const double lr = (double)p.lr[g * SN + n], li = (double)p.li[g * SN + n];
        const double ang = dt * li; const float rf = (float)(ang - rint(ang * 0.15915494309189535) * 6.283185307179586);
        const double mag = (double)expf((float)(dt * lr)), ar = mag * (double)cosf(rf), ai = mag * (double)sinf(rf), den = lr * lr + li * li;
        const double zr = ((ar - 1.0) * lr + ai * li) / den, zi = (ai * lr - (ar - 1.0) * li) / den;
        const double br = (double)p.br[(size_t)g * SN * 16 + idx], bi = (double)p.bi[(size_t)g * SN * 16 + idx];
        BB[idx] = (f32x2){(float)(zr * br - zi * bi), (float)(zr * bi + zi * br)}; }
    for (int idx = tid; idx < 16 * 64; idx += NTHREADS) CC[idx] = (f32x2){p.cr[(size_t)g * 1024 + idx], p.ci[(size_t)g * 1024 + idx]};
    __syncthreads();
    float* KC = (float*)(a.ws + WS_KC) + (size_t)(g * 2 + dir) * 32 * 256;
    for (int idx = tid; idx < 32 * 256; idx += NTHREADS) { const int t = idx >> 8, c = (idx >> 4) & 15, cp = idx & 15; float s = 0.f;
#pragma unroll 4
        for (int n = 0; n < 64; ++n) { const f32x2 cc = CC[c * 64 + n], ap = AP[t * 64 + n], bb = BB[n * 16 + cp];
            const float qr = cc.x * ap.x - cc.y * ap.y, qi = cc.x * ap.y + cc.y * ap.x; s += qr * bb.x - qi * bb.y; }
        KC[idx] = s; }
    bf16_t* BtE = (bf16_t*)(a.ws + WS_BTE) + ((size_t)g * 256 + dir * 128) * 512;
    for (int idx = tid; idx < 128 * 512; idx += NTHREADS) { const int cl = idx >> 9, k = idx & 511, q = cl >> 6, n = cl & 63, j = k >> 4, cp = k & 15;
        const f32x2 ap = AP[(dir ? j : 31 - j) * 64 + n], bb = BB[n * 16 + cp];
        const float v = q ? (ap.x * bb.y + ap.y * bb.x) : (ap.x * bb.x - ap.y * bb.y);
        BtE[idx] = f2bf(v); }
    bf16_t* BtY = (bf16_t*)(a.ws + WS_BTY) + (size_t)g * 512 * 768 + 512 + dir * 128;
    for (int idx = tid; idx < 512 * 128; idx += NTHREADS) { const int rn = idx >> 7, kk = idx & 127, q = kk >> 6, n = kk & 63, i = rn >> 4, c = rn & 15;
        const f32x2 cc = CC[c * 64 + n], ap = AP[(dir ? 32 - i : i + 1) * 64 + n];
        const float v = q ? -(cc.x * ap.y + cc.y * ap.x) : (cc.x * ap.x - cc.y * ap.y);
        BtY[(size_t)rn * 768 + kk] = f2bf(v); }
    if (tid < 64) ((f32x2*)(a.ws + WS_AT))[(g * 2 + dir) * 64 + tid] = AP[32 * 64 + tid];
    __syncthreads();
}

__device__ __forceinline__ void p0_prologue(const Args& a, LAS unsigned char* lds, int bx, int tid, int gw, int NGW, int wave, int lane) {
    unsigned char* ws = a.ws;
    if (bx < 2 * NG) p0_s5_tables(a, lds, bx >> 1, bx & 1, tid);
    LAS float* scr = (LAS float*)(lds + wave * 16384);
    constexpr int I_IN = (D / 64) * (INW / 32), I_GLU = (SW / 64) * (SW / 32), I_OUT = (D / 64) * (D / 32), I_FI = (D / 64) * (2 * FH / 32), I_FO = (FH / 64) * (D / 32);
    constexpr int NITEMS = I_IN + I_GLU + I_OUT + I_FI + I_FO;
    for (int it = gw; it < NITEMS; it += NGW) {
        int r = it;
        if (r < I_IN) { const int nb = INW / 32; transpose_item(a.in[I_WIN], INW, (bf16_t*)(ws + WS_WIN), D, 32 * (r % nb), scr, 64 * (r / nb), 32 * (r % nb), lane); continue; } r -= I_IN;
        if (r < I_GLU) { const int nb = SW / 32; transpose_item(a.in[I_WGLU], SW, (bf16_t*)(ws + WS_WGLU), SW, 32 * (r % nb), scr, 64 * (r / nb), 32 * (r % nb), lane); continue; } r -= I_GLU;
        if (r < I_OUT) { const int nb = D / 32; transpose_item(a.in[I_WOUT], D, (bf16_t*)(ws + WS_WOUT), D, 32 * (r % nb), scr, 64 * (r / nb), 32 * (r % nb), lane); continue; } r -= I_OUT;
        if (r < I_FI) { const int nb = 2 * FH / 32; const int n0 = 32 * (r % nb); const int half = n0 >= FH ? 1 : 0; const int nn = n0 - half * FH;
            transpose_item(a.in[I_WFFNIN], 2 * FH, (bf16_t*)(ws + WS_WFI), D, (nn >> 7) * 256 + half * 128 + (nn & 127), scr, 64 * (r / nb), n0, lane); continue; } r -= I_FI;
        { const int nb = D / 32; transpose_item(a.in[I_WFFNOUT], D, (bf16_t*)(ws + WS_WFO), FH, 32 * (r % nb), scr, 64 * (r / nb), 32 * (r % nb), lane); }
    }
    float* MOD = (float*)(ws + WS_MOD);
    for (int it = gw; it < 24 * 16; it += NGW) {
        const int cg_ = it % 24, kc = it / 24; const int col = cg_ * 256 + lane * 4;
        pg8::f32x4 acc[9];
#pragma unroll
        for (int r = 0; r < 9; ++r) acc[r] = (pg8::f32x4){0.f, 0.f, 0.f, 0.f};
        if (kc == 0) { const pg8::f32x4 bb = *(const pg8::f32x4*)(a.in[I_BMOD] + col);
#pragma unroll
            for (int r = 0; r < 9; ++r) acc[r] = bb; }
        for (int k = kc * 64; k < kc * 64 + 64; ++k) {
            const pg8::f32x4 w = *(const pg8::f32x4*)(a.in[I_WMOD] + (size_t)k * 6 * D + col);
#pragma unroll
            for (int r = 0; r < 9; ++r) { const float cv = r < 8 ? a.in[I_C][r * D + k] : a.in[I_CCTX][k]; acc[r] += w * silu_f(cv); }
        }
#pragma unroll
        for (int r = 0; r < 9; ++r)
#pragma unroll
            for (int j = 0; j < 4; ++j) atomicAdd(MOD + r * 6 * D + col + j, acc[r][j]);
    }
    float* ROPE = (float*)(ws + WS_ROPE);
    for (int e = gw * 64 + lane; e < 64 * 32; e += NGW * 64) {
        const int pos = e >> 5, f = e & 31; const float inv = powf(10000.0f, -(float)f / 32.0f); const float ang = (float)pos * inv;
        ROPE[2 * e] = cosf(ang); ROPE[2 * e + 1] = sinf(ang);
    }
}

__device__ __forceinline__ void p1_norm1(const Args& a, int gw, int NGW, int lane) {
    const float* MOD = (const float*)(a.ws + WS_MOD); bf16_t* H = (bf16_t*)(a.ws + WS_H); const float* g = a.in[I_GPREMIX];
    for (int row = gw; row < MT; row += NGW) {
        const float* xr; int mr;
        if (row < ML) { xr = a.in[I_X] + (size_t)row * D; mr = row >> 11; } else { xr = a.in[I_CTX] + (size_t)(row - ML) * D; mr = 8; }
        pg8::f32x4 v[4]; float s = 0.f;
#pragma unroll
        for (int j = 0; j < 4; ++j) { v[j] = *(const pg8::f32x4*)(xr + 4 * lane + 256 * j); s += (v[j][0] * v[j][0] + v[j][1] * v[j][1]) + (v[j][2] * v[j][2] + v[j][3] * v[j][3]); }
        s = wave_sum(s); const float rstd = 1.0f / sqrtf(s * (1.0f / D) + EPS);
        const float* sh = MOD + mr * 6 * D, * sc = sh + D;
#pragma unroll
        for (int j = 0; j < 4; ++j) { const int k = 4 * lane + 256 * j;
            const pg8::f32x4 gg = *(const pg8::f32x4*)(g + k), s1 = *(const pg8::f32x4*)(sc + k), s0 = *(const pg8::f32x4*)(sh + k);
            const pg8::f32x4 o = v[j] * rstd * gg * (s1 + 1.0f) + s0;
            unsigned long long w = (unsigned long long)pg8::cvt_pk_bf16(o[0], o[1]) | ((unsigned long long)pg8::cvt_pk_bf16(o[2], o[3]) << 32);
            *(unsigned long long*)(H + (size_t)row * D + k) = w; }
    }
}

__device__ __forceinline__ void p1_s5_toeplitz(const Args& a, int gtid, int NT) {
    const float* KC = (const float*)(a.ws + WS_KC); bf16_t* BtY = (bf16_t*)(a.ws + WS_BTY); const float* dv = a.in[I_S5D];
    for (int it = gtid; it < NG * 512 * 64; it += NT) {
        const int g = it >> 15, rn = (it >> 6) & 511, j = (it >> 1) & 31, hh = it & 1, i = rn >> 4, c = rn & 15, t = i - j;
        pg8::f32x4 v0, v1;
        if (t != 0) { const float* src = KC + ((size_t)(g * 2 + (t < 0 ? 1 : 0)) * 32 + (t < 0 ? -t : t)) * 256 + c * 16 + hh * 8; v0 = *(const pg8::f32x4*)src; v1 = *(const pg8::f32x4*)(src + 4); }
        else { const float* sf = KC + ((size_t)(g * 2) * 32) * 256 + c * 16 + hh * 8; const float* sb = KC + ((size_t)(g * 2 + 1) * 32) * 256 + c * 16 + hh * 8;
            v0 = *(const pg8::f32x4*)sf + *(const pg8::f32x4*)sb; v1 = *(const pg8::f32x4*)(sf + 4) + *(const pg8::f32x4*)(sb + 4);
            const float dd = dv[g * 16 + c]; const int cl = c - hh * 8;
#pragma unroll
            for (int e = 0; e < 4; ++e) { v0[e] += (cl == e) ? dd : 0.f; v1[e] += (cl == e + 4) ? dd : 0.f; } }
        *(pg8::u32x4*)(BtY + ((size_t)g * 512 + rn) * 768 + j * 16 + hh * 8) = pg8::pack8(v0, v1);
    }
}
__device__ __forceinline__ void p4_s5_scan(const Args& a, int gtid, int NT) {
    typedef float f32x2 __attribute__((ext_vector_type(2)));
    for (int idx = gtid; idx < NG * BATCH * 2 * 64; idx += NT) {
        const int n = idx & 63, dir = (idx >> 6) & 1, b = (idx >> 7) & 7, g = idx >> 10;
        const f32x2 aT = ((const f32x2*)(a.ws + WS_AT))[(g * 2 + dir) * 64 + n];
        const float* E = (const float*)(a.ws + WS_E) + (size_t)g * 768 * 256 + dir * 128 + n;
        bf16_t* Hs = (bf16_t*)(a.ws + WS_UA) + (size_t)g * 768 * 768 + 512 + dir * 128 + n;
        float hr = 0.f, hi = 0.f;
#pragma unroll
        for (int kk = 0; kk < 8; ++kk) { const int k = dir ? 7 - kk : kk; const float* e = E + (size_t)(512 + b * 8 + k) * 256; const float er = e[0], ei = e[64];
            const float nr = aT.x * hr - aT.y * hi + er, ni = aT.x * hi + aT.y * hr + ei; hr = nr; hi = ni; }
#pragma unroll 8
        for (int kk = 0; kk < 64; ++kk) { const int k = dir ? 63 - kk : kk; const int row = b * 64 + k; const float* e = E + (size_t)row * 256; const float er = e[0], ei = e[64];
            Hs[(size_t)row * 768] = f2bf(hr); Hs[(size_t)row * 768 + 64] = f2bf(hi);
            const float nr = aT.x * hr - aT.y * hi + er, ni = aT.x * hi + aT.y * hr + ei; hr = nr; hi = ni; }
    }
}

constexpr int PS_ = 132, PR_ = 136;
constexpr float LOG2E = 1.4426950408889634f;
typedef unsigned long long u64_t;
__device__ __forceinline__ pg8::bf16x8 lds_strided8(const LAS unsigned short* p, int s) {
    pg8::bf16x8 r;
#pragma unroll
    for (int jj = 0; jj < 8; ++jj) r[jj] = (short)p[(32 * s + (jj & 3) + 16 * (jj >> 2)) * PS_];
    return r;
}
__device__ __forceinline__ pg8::u32x4 scale8(const pg8::u32x4 v, float w) {
    pg8::u32x4 o;
    o.x = pg8::cvt_pk_bf16(pg8::bflo(v.x) * w, pg8::bfhi(v.x) * w); o.y = pg8::cvt_pk_bf16(pg8::bflo(v.y) * w, pg8::bfhi(v.y) * w);
    o.z = pg8::cvt_pk_bf16(pg8::bflo(v.z) * w, pg8::bfhi(v.z) * w); o.w = pg8::cvt_pk_bf16(pg8::bflo(v.w) * w, pg8::bfhi(v.w) * w);
    return o;
}
__device__ __forceinline__ void lds_w16(LAS unsigned short* p, const pg8::u32x4 v) {
    *(LAS u64_t*)p = (u64_t)v.x | ((u64_t)v.y << 32); *(LAS u64_t*)(p + 4) = (u64_t)v.z | ((u64_t)v.w << 32);
}
__device__ __forceinline__ void r1_unit(const Args& a, LAS unsigned char* lds, int unit, int tid, int wave, int lane) {
    asm volatile("" : "+v"(tid), "+v"(lane));
    const int ck = unit % 18, bh = unit / 18, b = bh >> 2, h = bh & 3;
    const size_t row0 = ck < 2 ? (size_t)ML + b * CTX + ck * 128 : (size_t)b * SEQ + (ck - 2) * 128;
    const bf16_t* QKVG = (const bf16_t*)(a.ws + WS_QKVG);
    LAS unsigned short* Kimg = (LAS unsigned short*)lds; LAS unsigned short* Vf = Kimg + 128 * PS_; LAS unsigned short* Vb = Vf + 128 * PS_;
    const float lf2 = -expf(a.in[I_DECF][h]) * LOG2E, lb2 = -expf(a.in[I_DECB][h]) * LOG2E;
#pragma unroll
    for (int it = 0; it < 4; ++it) { const int p = tid + it * NTHREADS; const int c = p >> 4, c16 = p & 15;
        const bf16_t* src = QKVG + (row0 + c) * 2048 + h * DH + c16 * 8;
        const pg8::u32x4 kk = *(const pg8::u32x4*)(src + 512), vv = *(const pg8::u32x4*)(src + 1024);
        lds_w16(Kimg + c * PS_ + c16 * 8, kk);
        lds_w16(Vf + c * PS_ + c16 * 8, scale8(vv, __builtin_amdgcn_exp2f(lf2 * (float)(127 - c))));
        lds_w16(Vb + c * PS_ + c16 * 8, scale8(vv, __builtin_amdgcn_exp2f(lb2 * (float)c))); }
    __syncthreads();
    const int dir = wave >> 2, eb = (wave & 3) * 32, fr = lane & 15, g = lane >> 4;
    const LAS unsigned short* Vd = dir ? Vb : Vf;
    pg8::f32x4 acc[8][2];
#pragma unroll
    for (int dt = 0; dt < 8; ++dt) { acc[dt][0] = (pg8::f32x4){0.f, 0.f, 0.f, 0.f}; acc[dt][1] = (pg8::f32x4){0.f, 0.f, 0.f, 0.f}; }
#pragma unroll
    for (int ks = 0; ks < 4; ++ks) {
        const pg8::bf16x8 b0 = lds_strided8(Vd + 4 * g * PS_ + eb + fr, ks), b1 = lds_strided8(Vd + 4 * g * PS_ + eb + 16 + fr, ks);
#pragma unroll
        for (int dt = 0; dt < 8; ++dt) { const pg8::bf16x8 af = lds_strided8(Kimg + 4 * g * PS_ + 16 * dt + fr, ks);
            acc[dt][0] = __builtin_amdgcn_mfma_f32_16x16x32_bf16(af, b0, acc[dt][0], 0, 0, 0);
            acc[dt][1] = __builtin_amdgcn_mfma_f32_16x16x32_bf16(af, b1, acc[dt][1], 0, 0, 0); }
    }
    bf16_t* KV = (bf16_t*)a.out + ((size_t)(bh * 2 + dir) * 18 + ck) * 16384;
#pragma unroll
    for (int dt = 0; dt < 8; ++dt)
#pragma unroll
        for (int et = 0; et < 2; ++et) { const int e = eb + 16 * et + fr, d0 = 16 * dt + 4 * g; const pg8::f32x4 v = acc[dt][et];
            *(u64_t*)(KV + e * 128 + d0) = (u64_t)pg8::cvt_pk_bf16(v[0], v[1]) | ((u64_t)pg8::cvt_pk_bf16(v[2], v[3]) << 32); }
    __syncthreads();
}
__device__ __forceinline__ void r2_scan(const Args& a, int gtid, int NT) {
    const bf16_t* KVb = (const bf16_t*)a.out; bf16_t* Sb = (bf16_t*)(a.ws + WS_H);
    for (int it = gtid; it < 64 * 2048; it += NT) {
        const int bhd = it >> 11, v8 = it & 2047, dir = bhd & 1, h = (bhd >> 1) & 3;
        const float dc = __builtin_amdgcn_exp2f(-expf(a.in[dir ? I_DECB : I_DECF][h]) * LOG2E * 128.0f);
        const bf16_t* kv = KVb + (size_t)bhd * 18 * 16384 + v8 * 8; bf16_t* S = Sb + (size_t)bhd * 16 * 16384 + v8 * 8;
        float s[8];
#pragma unroll
        for (int j = 0; j < 8; ++j) s[j] = 0.f;
#define R2_STEP(ckk) do { const pg8::u32x4 w = *(const pg8::u32x4*)(kv + (size_t)(ckk) * 16384); \
        s[0] = dc * s[0] + pg8::bflo(w.x); s[1] = dc * s[1] + pg8::bfhi(w.x); s[2] = dc * s[2] + pg8::bflo(w.y); s[3] = dc * s[3] + pg8::bfhi(w.y); \
        s[4] = dc * s[4] + pg8::bflo(w.z); s[5] = dc * s[5] + pg8::bfhi(w.z); s[6] = dc * s[6] + pg8::bflo(w.w); s[7] = dc * s[7] + pg8::bfhi(w.w); } while (0)
#define R2_OUT(n) do { pg8::u32x4 o; o.x = pg8::cvt_pk_bf16(s[0], s[1]); o.y = pg8::cvt_pk_bf16(s[2], s[3]); o.z = pg8::cvt_pk_bf16(s[4], s[5]); o.w = pg8::cvt_pk_bf16(s[6], s[7]); \
        *(pg8::u32x4*)(S + (size_t)(n) * 16384) = o; } while (0)
        if (dir == 0) { R2_STEP(0); R2_STEP(1);
#pragma unroll
            for (int n = 0; n < 16; ++n) { R2_OUT(n); R2_STEP(2 + n); } }
        else { R2_STEP(1); R2_STEP(0);
#pragma unroll
            for (int n = 15; n >= 0; --n) { R2_OUT(n); R2_STEP(2 + n); } }
#undef R2_STEP
#undef R2_OUT
    }
}
__device__ __forceinline__ void r3_unit(const Args& a, LAS unsigned char* lds, int unit, int tid, int wave, int lane) {
    asm volatile("" : "+v"(tid), "+v"(lane));
    const int n = unit & 15, bh = unit >> 4, b = bh >> 2, h = bh & 3;
    const size_t row0 = (size_t)b * SEQ + n * 128;
    const bf16_t* QKVG = (const bf16_t*)(a.ws + WS_QKVG); const bf16_t* Sb = (const bf16_t*)(a.ws + WS_H);
    LAS unsigned short* Kimg = (LAS unsigned short*)lds;
    LAS unsigned short* Vimg = Kimg + 128 * PR_;
    LAS unsigned short* SFimg = Vimg + 128 * PS_;
    LAS unsigned short* SBimg = SFimg + 128 * PR_;
    const float lf2 = -expf(a.in[I_DECF][h]) * LOG2E, lb2 = -expf(a.in[I_DECB][h]) * LOG2E;
    const bf16_t* SF = Sb + ((size_t)(bh * 2 + 0) * 16 + n) * 16384; const bf16_t* SB = Sb + ((size_t)(bh * 2 + 1) * 16 + n) * 16384;
#pragma unroll
    for (int it = 0; it < 4; ++it) { const int p = tid + it * NTHREADS; const int c = p >> 4, c16 = p & 15;
        const bf16_t* src = QKVG + (row0 + c) * 2048 + h * DH + c16 * 8;
        *(LAS pg8::u32x4*)(Kimg + c * PR_ + c16 * 8) = *(const pg8::u32x4*)(src + 512);
        lds_w16(Vimg + c * PS_ + c16 * 8, *(const pg8::u32x4*)(src + 1024));
        *(LAS pg8::u32x4*)(SFimg + c * PR_ + c16 * 8) = *(const pg8::u32x4*)(SF + c * 128 + c16 * 8);
        *(LAS pg8::u32x4*)(SBimg + c * PR_ + c16 * 8) = *(const pg8::u32x4*)(SB + c * 128 + c16 * 8); }
    const int fr = lane & 15, g = lane >> 4, il = 16 * wave + fr;
    pg8::bf16x8 qf[4];
#pragma unroll
    for (int ks = 0; ks < 4; ++ks) qf[ks] = *(const pg8::bf16x8*)(QKVG + (row0 + il) * 2048 + h * DH + 32 * ks + 8 * g);
    __syncthreads();
    pg8::bf16x8 pf[4];
#pragma unroll
    for (int s = 0; s < 4; ++s) {
        pg8::f32x4 sc[2];
#pragma unroll
        for (int t2 = 0; t2 < 2; ++t2) { const int jt = 2 * s + t2; sc[t2] = (pg8::f32x4){0.f, 0.f, 0.f, 0.f};
#pragma unroll
            for (int ks = 0; ks < 4; ++ks) { const pg8::bf16x8 kf = *(const LAS pg8::bf16x8*)(Kimg + (16 * jt + fr) * PR_ + 32 * ks + 8 * g);
                sc[t2] = __builtin_amdgcn_mfma_f32_16x16x32_bf16(kf, qf[ks], sc[t2], 0, 0, 0); }
#pragma unroll
            for (int r = 0; r < 4; ++r) { const int j = 16 * jt + 4 * g + r; const int df = il - j;
                sc[t2][r] *= __builtin_amdgcn_exp2f(df >= 0 ? lf2 * (float)df : lb2 * (float)(-df)); } }
        pg8::u32x4 w; w.x = pg8::cvt_pk_bf16(sc[0][0], sc[0][1]); w.y = pg8::cvt_pk_bf16(sc[0][2], sc[0][3]); w.z = pg8::cvt_pk_bf16(sc[1][0], sc[1][1]); w.w = pg8::cvt_pk_bf16(sc[1][2], sc[1][3]);
        pf[s] = __builtin_bit_cast(pg8::bf16x8, w);
    }
    const float cf = __builtin_amdgcn_exp2f(lf2 * (float)(il + 1)), cb = __builtin_amdgcn_exp2f(lb2 * (float)(128 - il));
    pg8::f32x4 o[8];
#pragma unroll
    for (int et = 0; et < 8; ++et) {
        pg8::f32x4 ai = (pg8::f32x4){0.f, 0.f, 0.f, 0.f}, af = ai, ab = ai;
#pragma unroll
        for (int s = 0; s < 4; ++s) { const pg8::bf16x8 vf = lds_strided8(Vimg + 4 * g * PS_ + 16 * et + fr, s);
            ai = __builtin_amdgcn_mfma_f32_16x16x32_bf16(vf, pf[s], ai, 0, 0, 0); }
#pragma unroll
        for (int ks = 0; ks < 4; ++ks) { const pg8::bf16x8 sf = *(const LAS pg8::bf16x8*)(SFimg + (16 * et + fr) * PR_ + 32 * ks + 8 * g);
            const pg8::bf16x8 sb = *(const LAS pg8::bf16x8*)(SBimg + (16 * et + fr) * PR_ + 32 * ks + 8 * g);
            af = __builtin_amdgcn_mfma_f32_16x16x32_bf16(sf, qf[ks], af, 0, 0, 0);
            ab = __builtin_amdgcn_mfma_f32_16x16x32_bf16(sb, qf[ks], ab, 0, 0, 0); }
        o[et] = ai + af * cf + ab * cb;
    }
    float s1 = 0.f;
#pragma unroll
    for (int et = 0; et < 8; ++et) s1 += (o[et][0] + o[et][1]) + (o[et][2] + o[et][3]);
    s1 += __shfl_xor(s1, 16); s1 += __shfl_xor(s1, 32);
    const float mu = s1 * (1.0f / DH); float s2 = 0.f;
#pragma unroll
    for (int et = 0; et < 8; ++et) { o[et] = o[et] - mu; s2 += (o[et][0] * o[et][0] + o[et][1] * o[et][1]) + (o[et][2] * o[et][2] + o[et][3] * o[et][3]); }
    s2 += __shfl_xor(s2, 16); s2 += __shfl_xor(s2, 32);
    const float rstd = 1.0f / sqrtf(s2 * (1.0f / DH) + EPS);
    const bf16_t* gsrc = QKVG + (row0 + il) * 2048 + 1536 + h * DH + 4 * g; const float* gn = a.in[I_GN] + h * DH + 4 * g;
    bf16_t* dst = (bf16_t*)a.out + (row0 + il) * D + h * DH + 4 * g;
#pragma unroll
    for (int et = 0; et < 8; ++et) { const u64_t gw_ = *(const u64_t*)(gsrc + 16 * et); const pg8::f32x4 gg = *(const pg8::f32x4*)(gn + 16 * et);
        const unsigned glo = (unsigned)gw_, ghi = (unsigned)(gw_ >> 32);
        const float y0 = fsilu(pg8::bflo(glo)) * (o[et][0] * rstd * gg[0]), y1 = fsilu(pg8::bfhi(glo)) * (o[et][1] * rstd * gg[1]);
        const float y2 = fsilu(pg8::bflo(ghi)) * (o[et][2] * rstd * gg[2]), y3 = fsilu(pg8::bfhi(ghi)) * (o[et][3] * rstd * gg[3]);
        *(u64_t*)(dst + 16 * et) = (u64_t)pg8::cvt_pk_bf16(y0, y1) | ((u64_t)pg8::cvt_pk_bf16(y2, y3) << 32); }
    __syncthreads();
}
__device__ __forceinline__ void p8_norm2(const Args& a, int gw, int NGW, int lane) {
    const float* MOD = (const float*)(a.ws + WS_MOD); const float* Y1 = (const float*)(a.ws + WS_Y1); bf16_t* H2 = (bf16_t*)(a.ws + WS_H);
    const float* gpost = a.in[I_GPOSTMIX]; const float* gpre = a.in[I_GPREFFN];
    for (int row = gw; row < ML; row += NGW) {
        const float* md = MOD + (row >> 11) * 6 * D;
        pg8::f32x4 y[4], xv[4]; float s = 0.f;
#pragma unroll
        for (int j = 0; j < 4; ++j) { y[j] = *(const pg8::f32x4*)(Y1 + (size_t)row * D + 4 * lane + 256 * j); s += (y[j][0] * y[j][0] + y[j][1] * y[j][1]) + (y[j][2] * y[j][2] + y[j][3] * y[j][3]); }
        s = wave_sum(s); const float rs1 = 1.0f / sqrtf(s * (1.0f / D) + EPS);
        float s2 = 0.f;
#pragma unroll
        for (int j = 0; j < 4; ++j) { const int k = 4 * lane + 256 * j;
            const pg8::f32x4 xx = *(const pg8::f32x4*)(a.in[I_X] + (size_t)row * D + k), gt = *(const pg8::f32x4*)(md + 2 * D + k), gp = *(const pg8::f32x4*)(gpost + k);
            xv[j] = xx + gt * (y[j] * rs1 * gp); s2 += (xv[j][0] * xv[j][0] + xv[j][1] * xv[j][1]) + (xv[j][2] * xv[j][2] + xv[j][3] * xv[j][3]); }
        s2 = wave_sum(s2); const float rs2 = 1.0f / sqrtf(s2 * (1.0f / D) + EPS);
#pragma unroll
        for (int j = 0; j < 4; ++j) { const int k = 4 * lane + 256 * j;
            *(pg8::f32x4*)(a.out + (size_t)row * D + k) = xv[j];
            const pg8::f32x4 gg = *(const pg8::f32x4*)(gpre + k), s1 = *(const pg8::f32x4*)(md + 4 * D + k), s0 = *(const pg8::f32x4*)(md + 3 * D + k);
            const pg8::f32x4 o = xv[j] * rs2 * gg * (s1 + 1.0f) + s0;
            unsigned long long w = (unsigned long long)pg8::cvt_pk_bf16(o[0], o[1]) | ((unsigned long long)pg8::cvt_pk_bf16(o[2], o[3]) << 32);
            *(unsigned long long*)(H2 + (size_t)row * D + k) = w; }
    }
}
__device__ __forceinline__ void p11_final(const Args& a, int gw, int NGW, int lane) {
    const float* MOD = (const float*)(a.ws + WS_MOD); const float* Y2 = (const float*)(a.ws + WS_Y2); const float* gpost = a.in[I_GPOSTFFN];
    for (int row = gw; row < ML; row += NGW) {
        const float* md = MOD + (row >> 11) * 6 * D;
        pg8::f32x4 y[4]; float s = 0.f;
#pragma unroll
        for (int j = 0; j < 4; ++j) { y[j] = *(const pg8::f32x4*)(Y2 + (size_t)row * D + 4 * lane + 256 * j); s += (y[j][0] * y[j][0] + y[j][1] * y[j][1]) + (y[j][2] * y[j][2] + y[j][3] * y[j][3]); }
        s = wave_sum(s); const float rs = 1.0f / sqrtf(s * (1.0f / D) + EPS);
#pragma unroll
        for (int j = 0; j < 4; ++j) { const int k = 4 * lane + 256 * j;
            float* op = a.out + (size_t)row * D + k;
            const pg8::f32x4 x1 = *(const pg8::f32x4*)op, gt = *(const pg8::f32x4*)(md + 5 * D + k), gp = *(const pg8::f32x4*)(gpost + k);
            *(pg8::f32x4*)op = x1 + gt * (y[j] * rs * gp); }
    }
}

__global__ void __launch_bounds__(NTHREADS, 2) mk_fwd(Args a) {
    extern __shared__ __attribute__((aligned(16))) unsigned char lds_raw[];
    LAS unsigned char* lds = (LAS unsigned char*)lds_raw;
    cg::grid_group grid = cg::this_grid();
    const int tid = threadIdx.x, lane = tid & 63, wave = __builtin_amdgcn_readfirstlane(tid >> 6);
    const int G = gridDim.x, bx = blockIdx.x;
    const int gw = bx * NWAVES + wave, NGW = G * NWAVES;
    unsigned char* ws = a.ws;
    const int lo = a.ph_lo, hi = a.ph_hi;
#define IN(k) (lo <= (k) && (k) < hi)
#define SEAM(k) do { if (IN(k) && IN((k) + 1)) grid.sync(); } while (0)

    if (IN(0)) { p0_prologue(a, lds, bx, tid, gw, NGW, wave, lane); __syncthreads(); }
    SEAM(0);
    if (IN(1)) { p1_s5_toeplitz(a, bx * NTHREADS + tid, G * NTHREADS); p1_norm1(a, gw, NGW, lane); }
    SEAM(1);
    if (IN(2)) {
        pg8::Gemm g{(const bf16_t*)(ws + WS_H), (const bf16_t*)(ws + WS_WIN), D, D, D}; pg8::StaticOrder S; S.init(MT / 256, INW / 256, G, bx);
        pg8::EpiInProjM E{(bf16_t*)(ws + WS_QKVG), (bf16_t*)(ws + WS_UA), (const float*)(ws + WS_ROPE)};
        pg8::gemm_phase<pg8::EpiInProjM, pg8::StaticOrder, true, true>(lds, g, S, E);
    }
    SEAM(2);
    if (IN(3)) {
        pg8::Gemm g{(const bf16_t*)(ws + WS_UA), (const bf16_t*)(ws + WS_BTE), 768, 512, 512}; pg8::S5EOrder S{G, bx};
        pg8::EpiS5E E{(float*)(ws + WS_E)};
        pg8::gemm_phase<pg8::EpiS5E, pg8::S5EOrder, true, true>(lds, g, S, E);
        __syncthreads();
        for (int u = bx; u < 32 * 18; u += G) r1_unit(a, lds, u, tid, wave, lane);
    }
    SEAM(3);
    if (IN(4)) { p4_s5_scan(a, bx * NTHREADS + tid, G * NTHREADS); r2_scan(a, bx * NTHREADS + tid, G * NTHREADS); }
    SEAM(4);
    if (IN(5)) {
        pg8::Gemm g{(const bf16_t*)(ws + WS_UA), (const bf16_t*)(ws + WS_BTY), 768, 768, 768}; pg8::S5YOrder S{G, bx};
        pg8::EpiS5Y E{(bf16_t*)(ws + WS_Z)};
        pg8::gemm_phase<pg8::EpiS5Y, pg8::S5YOrder, true, true>(lds, g, S, E);
        __syncthreads();
        for (int u = bx; u < 32 * 16; u += G) r3_unit(a, lds, u, tid, wave, lane);
    }
    SEAM(5);
    if (IN(6)) {
        pg8::Gemm g{(const bf16_t*)(ws + WS_Z), (const bf16_t*)(ws + WS_WGLU), SW, SW, SW}; pg8::StaticOrder S; S.init(ML / 256, SW / 256, G, bx);
        pg8::EpiGluM E{(const bf16_t*)(ws + WS_Z), a.in[I_BGLU], (bf16_t*)a.out};
        pg8::gemm_phase<pg8::EpiGluM, pg8::StaticOrder, true, true>(lds, g, S, E);
    }
    SEAM(6);
    if (IN(7)) {
        pg8::Gemm g{(const bf16_t*)a.out, (const bf16_t*)(ws + WS_WOUT), D, D, D}; pg8::StaticOrder S; S.init(ML / 256, D / 256, G, bx);
        pg8::EpiF32M E{(float*)(ws + WS_Y1), D};
        pg8::gemm_phase<pg8::EpiF32M, pg8::StaticOrder, true, true>(lds, g, S, E);
    }
    SEAM(7);
    if (IN(8)) { p8_norm2(a, gw, NGW, lane); }
    SEAM(8);
    if (IN(9)) {
        pg8::Gemm g{(const bf16_t*)(ws + WS_H), (const bf16_t*)(ws + WS_WFI), D, D, D}; pg8::StaticOrder S; S.init(ML / 256, 2 * FH / 256, G, bx);
        pg8::EpiSwigluM E{(bf16_t*)(ws + WS_HID)};
        pg8::gemm_phase<pg8::EpiSwigluM, pg8::StaticOrder, true, true>(lds, g, S, E);
    }
    SEAM(9);
    if (IN(10)) {
        pg8::Gemm g{(const bf16_t*)(ws + WS_HID), (const bf16_t*)(ws + WS_WFO), FH, FH, FH}; pg8::StaticOrder S; S.init(ML / 256, D / 256, G, bx);
        pg8::EpiF32M E{(float*)(ws + WS_Y2), D};
        pg8::gemm_phase<pg8::EpiF32M, pg8::StaticOrder, true, true>(lds, g, S, E);
    }
    SEAM(10);
    if (IN(11)) { p11_final(a, gw, NGW, lane); }
#undef IN
#undef SEAM
}

#ifdef NAIVE_RET
__global__ __launch_bounds__(128) void k_ret_naive(const bf16_t* QKVG, const float* decf, const float* decb, const float* gn, bf16_t* MIX) {
    const int i = blockIdx.x % SEQ, h = (blockIdx.x / SEQ) % NH, b = blockIdx.x / (SEQ * NH), t = threadIdx.x;
    __shared__ float sq[128]; __shared__ float sp[SEQ + CTX]; __shared__ float red[2][2];
    const size_t row = (size_t)b * SEQ + i;
    sq[t] = bf2f(QKVG[row * 2048 + h * DH + t]);
    __syncthreads();
    const float lgf = -expf(decf[h]), lgb = -expf(decb[h]);
    for (int kk = t; kk < SEQ + CTX; kk += 128) {
        size_t krow; float w;
        if (kk < SEQ) { krow = (size_t)b * SEQ + kk; w = (kk <= i) ? expf(lgf * (float)(i - kk)) : expf(lgb * (float)(kk - i)); }
        else { const int tc = kk - SEQ; krow = (size_t)ML + b * CTX + tc; w = expf(lgf * (float)(i + CTX - tc)) + expf(lgb * (float)(SEQ + tc - i)); }
        const bf16_t* kp = QKVG + krow * 2048 + 512 + h * DH;
        float s = 0.f;
        for (int d = 0; d < DH; ++d) s += sq[d] * bf2f(kp[d]);
        sp[kk] = s * w;
    }
    __syncthreads();
    float o = 0.f;
    for (int kk = 0; kk < SEQ + CTX; ++kk) {
        const size_t krow = kk < SEQ ? (size_t)b * SEQ + kk : (size_t)ML + b * CTX + (kk - SEQ);
        o += sp[kk] * bf2f(QKVG[krow * 2048 + 1024 + h * DH + t]);
    }
    float s1 = wave_sum(o);
    if ((t & 63) == 0) red[0][t >> 6] = s1;
    __syncthreads();
    const float mu = (red[0][0] + red[0][1]) / DH;
    const float dv = o - mu;
    float s2 = wave_sum(dv * dv);
    if ((t & 63) == 0) red[1][t >> 6] = s2;
    __syncthreads();
    const float var = (red[1][0] + red[1][1]) / DH;
    const float on = dv / sqrtf(var + EPS) * gn[h * DH + t];
    const float gate = bf2f(QKVG[row * 2048 + 1536 + h * DH + t]);
    MIX[row * 1024 + h * DH + t] = f2bf(silu_f(gate) * on);
}

#endif
static void launch_phases(const Args& base, int lo, int hi, int grid, hipStream_t stream) {
    Args a = base; a.ph_lo = lo; a.ph_hi = hi;
    hipLaunchKernelGGL(mk_fwd, dim3(grid), dim3(NTHREADS), LDS_BYTES, stream, a);
}
extern "C" void kernel_launch(void* const* d_in, const int* in_sizes, int n_in, void* d_out, int out_size, void* d_ws, size_t ws_size, hipStream_t stream) {
    (void)in_sizes; (void)n_in; (void)out_size; (void)ws_size;
    static int grid = 0;
    if (grid == 0) {
        int dev = 0, cus = 0, per_cu = 0;
        (void)hipGetDevice(&dev); (void)hipDeviceGetAttribute(&cus, hipDeviceAttributeMultiprocessorCount, dev);
        (void)hipFuncSetAttribute((const void*)mk_fwd, hipFuncAttributeMaxDynamicSharedMemorySize, LDS_BYTES);
        (void)hipOccupancyMaxActiveBlocksPerMultiprocessor(&per_cu, (const void*)mk_fwd, NTHREADS, LDS_BYTES);
        if (per_cu < 1) { fprintf(stderr, "kernel_launch: occupancy query reports %d blocks/CU\n", per_cu); per_cu = 1; }
        grid = cus * (per_cu < 1 ? 1 : 1);
        (void)hipGetLastError();
    }
    Args a{};
    for (int i = 0; i < N_IN; ++i) a.in[i] = (const float*)d_in[i];
    a.out = (float*)d_out; a.ws = (unsigned char*)d_ws;
    unsigned char* ws = (unsigned char*)d_ws;
    (void)hipMemsetAsync(ws + WS_CTL, 0, CTL_ZERO_BYTES, stream);
#ifdef MK_LAUNCH_PER_PHASE
    for (int p = 0; p < 12; ++p) launch_phases(a, p, p + 1, grid, stream);
#else
    a.ph_lo = 0; a.ph_hi = 12;
    void* kargs[] = {&a};
    const hipError_t e = hipLaunchCooperativeKernel((const void*)mk_fwd, dim3(grid), dim3(NTHREADS), kargs, LDS_BYTES, stream);
    if (e != hipSuccess) fprintf(stderr, "cooperative launch failed: %s (grid %d)\n", hipGetErrorString(e), grid);
#endif
}
```

```cpp
#include <hip/hip_runtime.h>
#include <hip/hip_cooperative_groups.h>
#include <cstdio>
#include <cstdint>
namespace cg = cooperative_groups;

typedef unsigned short bf16_t;
__device__ __forceinline__ float bf2f(bf16_t v) { return __uint_as_float(((unsigned)v) << 16); }
__device__ __forceinline__ bf16_t f2bf(float f) { unsigned u = __float_as_uint(f); u += 0x7fffu + ((u >> 16) & 1u); return (bf16_t)(u >> 16); }

constexpr int D = 1024, BATCH = 8, SEQ = 2048, CTX = 256;
constexpr int ML = BATCH * SEQ;
constexpr int MC = BATCH * CTX;
constexpr int MT = ML + MC;
constexpr int RW = 512, NH = 4, DH = 128;
constexpr int SW = 512, SG = 16, NG = 32, SN = 64;
constexpr int INW = 2560, FH = 2816;
constexpr int TCH = 32;
constexpr float EPS = 1e-6f;
constexpr float KSCALE = 0.08838834764831845f;

constexpr size_t MiB = 1u << 20;
constexpr size_t WS_CTL = 0, CTL_ZERO_BYTES = 1 * MiB;
constexpr size_t WS_MOD = 64 * 1024;
constexpr size_t WS_ROPE = 1 * MiB;
constexpr size_t WS_WIN = 2 * MiB;
constexpr size_t WS_WGLU = 7 * MiB;
constexpr size_t WS_WOUT = 8 * MiB;
constexpr size_t WS_WFI = 10 * MiB;
constexpr size_t WS_WFO = 21 * MiB;
constexpr size_t WS_BTE = 27 * MiB;
constexpr size_t WS_BTY = 35 * MiB;
constexpr size_t WS_H = 59 * MiB;
constexpr size_t WS_QKVG = 95 * MiB;
constexpr size_t WS_UA = 167 * MiB;
constexpr size_t WS_E = 203 * MiB;
constexpr size_t WS_KC = 228 * MiB;
constexpr size_t WS_AT = 231 * MiB;
constexpr size_t WS_Z = 235 * MiB;
constexpr size_t WS_Y1 = 95 * MiB;
constexpr size_t WS_HID = 95 * MiB;
constexpr size_t WS_Y2 = 27 * MiB;

enum { I_X = 0, I_C, I_CTX, I_CCTX, I_WMOD, I_BMOD, I_GPREMIX, I_GPOSTMIX, I_WIN, I_DECF, I_DECB, I_GN,
       I_LRF, I_LIF, I_LDTF, I_BRF, I_BIF, I_CRF, I_CIF,
       I_LRB, I_LIB, I_LDTB, I_BRB, I_BIB, I_CRB, I_CIB,
       I_S5D, I_WGLU, I_BGLU, I_WOUT, I_GPREFFN, I_GPOSTFFN, I_WFFNIN, I_WFFNOUT, N_IN };

__device__ __forceinline__ float silu_f(float v) { return v / (1.0f + expf(-v)); }
__device__ __forceinline__ float sigmoid_f(float v) { return 1.0f / (1.0f + expf(-v)); }
__device__ __forceinline__ float gelu_tanh_f(float v) { const float u = 0.7978845608028654f * (v + 0.044715f * v * v * v); return 0.5f * v * (1.0f + tanhf(u)); }
__device__ __forceinline__ float fsigmoid(float v) { return __builtin_amdgcn_rcpf(1.0f + __builtin_amdgcn_exp2f(-1.4426950408889634f * v)); }
__device__ __forceinline__ float fsilu(float v) { return v * fsigmoid(v); }
__device__ __forceinline__ float fgelu_tanh(float v) { const float u = 0.7978845608028654f * (v + 0.044715f * v * v * v); return v * fsigmoid(2.0f * u); }
__device__ __forceinline__ float wave_sum(float v) {
#pragma unroll
    for (int o = 1; o < 64; o <<= 1) v += __shfl_xor(v, o);
    return v;
}

namespace pg8 {
#define PG8_LAS __attribute__((address_space(3)))
typedef short bf16x8 __attribute__((ext_vector_type(8)));
typedef float f32x4 __attribute__((ext_vector_type(4)));
typedef unsigned u32x4 __attribute__((ext_vector_type(4)));
constexpr int BM = 256, BK = 64, HALF = 128, HTB = HALF * BK * 2  , STAGE_BYTES = 8 * HTB, NXCD = 8, WGM = 8;

__host__ __device__ __forceinline__ int lds_byte(int r, int c) { const int st = (r >> 4) * 2 + (c >> 5), rr = r & 15, cc = c & 31, ob = rr * 64 + cc * 2; return st * 1024 + (ob ^ (((ob >> 9) & 1) << 5)); }
__host__ __device__ __forceinline__ void stage_rc(int b, int& R, int& C) { const int st = b / 1024, sb = b % 1024, swz = sb ^ (((sb >> 9) & 1) << 5); R = (st >> 1) * 16 + swz / 64; C = (st & 1) * 32 + (swz % 64) / 2; }
__host__ __device__ __forceinline__ int perm32(int rho) { const int n = rho >> 4, i = rho & 15; return 8 * (i >> 2) + 4 * n + (i & 3); }

struct Unit { int pm, pn; };
struct Gemm { const bf16_t* A; const bf16_t* Bt; int lda, ldb, K; };

struct StaticOrder {
    int nM, nN, nwg, G, c;
    __device__ void init(int nM_, int nN_, int G_, int c_) { nM = nM_; nN = nN_; nwg = nM * nN; G = G_; c = c_; }
    __device__ bool next(int i, Unit& u) const {
        const long L = (long)i * G + c; if (L >= nwg) return false;
        int wgid = (int)L; { const int q = nwg / NXCD, r = nwg % NXCD, xcd = wgid % NXCD, off = wgid / NXCD; wgid = (xcd < r ? xcd * (q + 1) : r * (q + 1) + (xcd - r) * q) + off; }
        const int nig = WGM * nN, gid = wgid / nig, fm = gid * WGM, gsz = (nM - fm) < WGM ? (nM - fm) : WGM;
        u.pm = fm + ((wgid % nig) % gsz); u.pn = (wgid % nig) / gsz; return true;
    }
    __device__ __forceinline__ void a_ready(const Unit&) const {}
    __device__ __forceinline__ void done(const Unit&) const {}
};
struct S5EOrder {
    int G, c;
    __device__ bool next(int i, Unit& u) const { const int L = i * G + c; if (L >= 96) return false; u.pm = L; u.pn = L / 3; return true; }
    __device__ __forceinline__ void a_ready(const Unit&) const {}
    __device__ __forceinline__ void done(const Unit&) const {}
};
struct S5YOrder {
    int G, c;
    __device__ bool next(int i, Unit& u) const { const int L = i * G + c; if (L >= 128) return false; const int g = L >> 2; u.pm = 3 * g + ((L >> 1) & 1); u.pn = 2 * g + (L & 1); return true; }
    __device__ __forceinline__ void a_ready(const Unit&) const {}
    __device__ __forceinline__ void done(const Unit&) const {}
};

typedef __bf16 bf16x2_t __attribute__((ext_vector_type(2)));
typedef float f32x2_t __attribute__((ext_vector_type(2)));
__device__ __forceinline__ unsigned cvt_pk_bf16(float lo, float hi) { const f32x2_t v = {lo, hi}; return __builtin_bit_cast(unsigned, __builtin_convertvector(v, bf16x2_t)); }
__device__ __forceinline__ u32x4 pack8(const f32x4 v0, const f32x4 v1) { u32x4 w; w.x = cvt_pk_bf16(v0[0], v0[1]); w.y = cvt_pk_bf16(v0[2], v0[3]); w.z = cvt_pk_bf16(v1[0], v1[1]); w.w = cvt_pk_bf16(v1[2], v1[3]); return w; }
__device__ __forceinline__ float bflo(unsigned w) { return __uint_as_float(w << 16); }
__device__ __forceinline__ float bfhi(unsigned w) { return __uint_as_float(w & 0xffff0000u); }

struct EpiInProjM {
    static constexpr bool PERM = true, AFTER_DRAIN = false;
    bf16_t* QKVG; bf16_t* UA; const float* ROPE;
    __device__ __forceinline__ void operator()(const f32x4 (&acc)[2][2][4][2], const Unit& u, int wr, int wc, int fr, int fq) const {
        const int row0 = u.pm * BM + wr * 64 + fr; const int kind = u.pn >> 1; const bool lat = u.pm < 64;
#pragma unroll
        for (int ai = 0; ai < 2; ++ai)
#pragma unroll
            for (int m = 0; m < 4; ++m) {
                const int r = row0 + ai * HALF + m * 16;
                const int b = lat ? (r >> 11) : ((r - ML) >> 8); const int l = lat ? (r & 2047) : ((r - ML) & 255);
#pragma unroll
                for (int bj = 0; bj < 2; ++bj) {
                    const int c0 = u.pn * BM + bj * HALF + wc * 32 + 8 * fq;
                    f32x4 v0 = acc[ai][bj][m][0], v1 = acc[ai][bj][m][1];
                    if (kind <= 1) {
                        if (lat) {
                            const int p0 = 16 * wc + 4 * fq; const int pos = (wc < 2) ? (l >> 6) : (l & 63); const int f0 = p0 & 31;
                            const f32x4* rp = (const f32x4*)(ROPE + (size_t)(pos * 32 + f0) * 2);
                            const f32x4 cs01 = rp[0], cs23 = rp[1];
                            f32x4 t0, t1;
                            t0[0] = v0[0] * cs01[0] - v0[1] * cs01[1]; t0[1] = v0[0] * cs01[1] + v0[1] * cs01[0];
                            t0[2] = v0[2] * cs01[2] - v0[3] * cs01[3]; t0[3] = v0[2] * cs01[3] + v0[3] * cs01[2];
                            t1[0] = v1[0] * cs23[0] - v1[1] * cs23[1]; t1[1] = v1[0] * cs23[1] + v1[1] * cs23[0];
                            t1[2] = v1[2] * cs23[2] - v1[3] * cs23[3]; t1[3] = v1[2] * cs23[3] + v1[3] * cs23[2];
                            v0 = t0; v1 = t1;
                        }
                        if (kind == 1) { v0 = v0 * KSCALE; v1 = v1 * KSCALE; }
                    }
                    const u32x4 w = pack8(v0, v1);
                    if (kind < 4) *(u32x4*)(QKVG + (size_t)r * 2048 + c0) = w;
                    else { const int cu = c0 - 2048, g = cu >> 4, cc = cu & 15, chunk = l >> 5, jj = l & 31; const int rowA = lat ? b * 64 + chunk : 512 + b * 8 + chunk;
                        *(u32x4*)(UA + ((size_t)g * 768 + rowA) * 768 + jj * 16 + cc) = w; }
                }
            }
    }
};
struct EpiGluM {
    static constexpr bool PERM = true, AFTER_DRAIN = false;
    const bf16_t* Z; const float* bglu; bf16_t* MIX;
    __device__ __forceinline__ void operator()(const f32x4 (&acc)[2][2][4][2], const Unit& u, int wr, int wc, int fr, int fq) const {
        const int row0 = u.pm * BM + wr * 64 + fr;
#pragma unroll
        for (int bj = 0; bj < 2; ++bj) {
            const int c0 = u.pn * BM + bj * HALF + wc * 32 + 8 * fq;
            const f32x4 b0 = *(const f32x4*)(bglu + c0), b1 = *(const f32x4*)(bglu + c0 + 4);
#pragma unroll
            for (int ai = 0; ai < 2; ++ai)
#pragma unroll
                for (int m = 0; m < 4; ++m) {
                    const int r = row0 + ai * HALF + m * 16;
                    const u32x4 zz = *(const u32x4*)(Z + (size_t)r * SW + c0);
                    const f32x4 a0 = acc[ai][bj][m][0] + b0, a1 = acc[ai][bj][m][1] + b1;
                    f32x4 o0, o1;
                    o0[0] = bflo(zz.x) * fsigmoid(a0[0]); o0[1] = bfhi(zz.x) * fsigmoid(a0[1]); o0[2] = bflo(zz.y) * fsigmoid(a0[2]); o0[3] = bfhi(zz.y) * fsigmoid(a0[3]);
                    o1[0] = bflo(zz.z) * fsigmoid(a1[0]); o1[1] = bfhi(zz.z) * fsigmoid(a1[1]); o1[2] = bflo(zz.w) * fsigmoid(a1[2]); o1[3] = bfhi(zz.w) * fsigmoid(a1[3]);
                    *(u32x4*)(MIX + (size_t)r * D + 512 + c0) = pack8(o0, o1);
                }
        }
    }
};
struct EpiF32M {
    static constexpr bool PERM = false, AFTER_DRAIN = false;
    float* C; int ldc;
    __device__ __forceinline__ void operator()(const f32x4 (&acc)[2][2][4][2], const Unit& u, int wr, int wc, int fr, int fq) const {
        const int row0 = u.pm * BM + wr * 64 + fr, col0 = u.pn * BM + wc * 32 + 4 * fq;
#pragma unroll
        for (int ai = 0; ai < 2; ++ai)
#pragma unroll
            for (int m = 0; m < 4; ++m) { float* rowp = C + (size_t)(row0 + ai * HALF + m * 16) * ldc + col0;
#pragma unroll
                for (int bj = 0; bj < 2; ++bj)
#pragma unroll
                    for (int n = 0; n < 2; ++n) *(f32x4*)(rowp + bj * HALF + n * 16) = acc[ai][bj][m][n]; }
    }
};
struct EpiSwigluM {
    static constexpr bool PERM = true, AFTER_DRAIN = false;
    bf16_t* HID;
    __device__ __forceinline__ void operator()(const f32x4 (&acc)[2][2][4][2], const Unit& u, int wr, int wc, int fr, int fq) const {
        const int row0 = u.pm * BM + wr * 64 + fr, c0 = u.pn * HALF + wc * 32 + 8 * fq;
#pragma unroll
        for (int ai = 0; ai < 2; ++ai)
#pragma unroll
            for (int m = 0; m < 4; ++m) {
                const int r = row0 + ai * HALF + m * 16;
                f32x4 o[2];
#pragma unroll
                for (int n = 0; n < 2; ++n) { const f32x4 gt = acc[ai][0][m][n], up = acc[ai][1][m][n];
#pragma unroll
                    for (int j = 0; j < 4; ++j) o[n][j] = fsilu(gt[j]) * up[j]; }
                *(u32x4*)(HID + (size_t)r * FH + c0) = pack8(o[0], o[1]);
            }
    }
};
struct EpiS5E {
    static constexpr bool PERM = false, AFTER_DRAIN = false;
    float* E;
    __device__ __forceinline__ void operator()(const f32x4 (&acc)[2][2][4][2], const Unit& u, int wr, int wc, int fr, int fq) const {
        const int g = u.pn; const int rl0 = (u.pm - 3 * g) * BM + wr * 64 + fr, col0 = wc * 32 + 4 * fq;
#pragma unroll
        for (int ai = 0; ai < 2; ++ai)
#pragma unroll
            for (int m = 0; m < 4; ++m) { float* rowp = E + ((size_t)g * 768 + rl0 + ai * HALF + m * 16) * 256 + col0;
#pragma unroll
                for (int bj = 0; bj < 2; ++bj)
#pragma unroll
                    for (int n = 0; n < 2; ++n) *(f32x4*)(rowp + bj * HALF + n * 16) = acc[ai][bj][m][n]; }
    }
};
struct EpiS5Y {
    static constexpr bool PERM = true, AFTER_DRAIN = false;
    bf16_t* Z;
    __device__ __forceinline__ void operator()(const f32x4 (&acc)[2][2][4][2], const Unit& u, int wr, int wc, int fr, int fq) const {
        const int g = u.pn >> 1; const int rl0 = (u.pm - 3 * g) * BM + wr * 64 + fr;
#pragma unroll
        for (int ai = 0; ai < 2; ++ai)
#pragma unroll
            for (int m = 0; m < 4; ++m) {
                const int rl = rl0 + ai * HALF + m * 16; const int b = rl >> 6, chunk = rl & 63;
#pragma unroll
                for (int bj = 0; bj < 2; ++bj) {
                    const int cl = (u.pn & 1) * BM + bj * HALF + wc * 32 + 8 * fq; const int i = cl >> 4, c0 = cl & 15;
                    const size_t tok = (size_t)b * SEQ + chunk * TCH + i;
                    f32x4 o0, o1;
#pragma unroll
                    for (int j = 0; j < 4; ++j) { o0[j] = fgelu_tanh(acc[ai][bj][m][0][j]); o1[j] = fgelu_tanh(acc[ai][bj][m][1][j]); }
                    *(u32x4*)(Z + tok * SW + g * 16 + c0) = pack8(o0, o1);
                }
            }
    }
};

template <class Epi, class Sched, bool ALIGN_EPI = false, bool SP2 = false>
__device__ __forceinline__ void gemm_phase(PG8_LAS unsigned char* lds, const Gemm g, const Sched& S, const Epi& E) {
    const int tid = threadIdx.x, wid = __builtin_amdgcn_readfirstlane(tid >> 6), lane = tid & 63, wr = wid >> 2, wc = wid & 3, fr = lane & 15, fq = lane >> 4;
    const int K = g.K, nt = K / BK;
    unsigned voffA[2], voffB[2];
#pragma unroll
    for (int i = 0; i < 2; ++i) { int R, C; stage_rc(tid * 16 + i * 8192, R, C); const int Rb = Epi::PERM ? ((R & ~31) + perm32(R & 31)) : R;
        voffA[i] = (unsigned)(R * g.lda + C) * 2u; voffB[i] = (unsigned)(Rb * g.ldb + C) * 2u; }
    const size_t kstep = (size_t)(BK * 2);
    const size_t hstepA = (size_t)HALF * g.lda * 2, hstepB = (size_t)HALF * g.ldb * 2;
    const size_t tstepA = 2 * hstepA, tstepB = 2 * hstepB;
    const unsigned ldsw = (unsigned)wid * 1024u;
    const int aoff = lds_byte(wr * 64 + fr, fq * 8), boff = lds_byte(wc * 32 + fr, fq * 8);
#define PG8_SA(b, h) (((b) * 2 + (h)) * HTB)
#define PG8_SB(b, h) ((4 + (b) * 2 + (h)) * HTB)
#define PG8_STAGE(bufoff, gbase, voff) do { _Pragma("unroll") for (int _i = 0; _i < 2; ++_i) \
        __builtin_amdgcn_global_load_lds((const unsigned*)((const char*)(gbase) + (voff)[_i]), (PG8_LAS unsigned*)(lds + (bufoff) + ldsw + _i * 8192), 16, 0, 0); } while (0)
#define PG8_LDA(dst, b, h) do { _Pragma("unroll") for (int m = 0; m < 4; ++m) _Pragma("unroll") for (int k = 0; k < 2; ++k) dst[m][k] = *(const PG8_LAS bf16x8*)(lds + PG8_SA(b, h) + aoff + m * 2048 + k * 1024); } while (0)
#define PG8_LDB(dst, b, h) do { _Pragma("unroll") for (int n = 0; n < 2; ++n) _Pragma("unroll") for (int k = 0; k < 2; ++k) dst[n][k] = *(const PG8_LAS bf16x8*)(lds + PG8_SB(b, h) + boff + n * 2048 + k * 1024); } while (0)
#define PG8_MMA(ai, bj, At, Bt) do { __builtin_amdgcn_s_setprio(1); _Pragma("unroll") for (int m = 0; m < 4; ++m) _Pragma("unroll") for (int n = 0; n < 2; ++n) _Pragma("unroll") for (int k = 0; k < 2; ++k) \
        acc[ai][bj][m][n] = __builtin_amdgcn_mfma_f32_16x16x32_bf16(Bt[n][k], At[m][k], acc[ai][bj][m][n], 0, 0, 0); __builtin_amdgcn_s_setprio(0); } while (0)
#define PG8_WAIT_V(n) asm volatile("s_waitcnt vmcnt(" #n ")" ::: "memory")
#define PG8_WAIT_L(n) asm volatile("s_waitcnt lgkmcnt(" #n ")" ::: "memory")
#define PG8_BAR __builtin_amdgcn_s_barrier()
#define PG8_SCHED __builtin_amdgcn_sched_barrier(0)
    Unit cur, nxt; int ui = 0;
    if (!S.next(0, cur)) return;
    f32x4 acc[2][2][4][2];
#pragma unroll
    for (int a = 0; a < 2; ++a)
#pragma unroll
        for (int b = 0; b < 2; ++b)
#pragma unroll
            for (int m = 0; m < 4; ++m)
#pragma unroll
                for (int n = 0; n < 2; ++n) acc[a][b][m][n] = (f32x4){0.f, 0.f, 0.f, 0.f};
    bf16x8 At[4][2], B0[2][2], B1[2][2];
    const char* cA = (const char*)g.A + (size_t)cur.pm * tstepA; const char* cB = (const char*)g.Bt + (size_t)cur.pn * tstepB;
    S.a_ready(cur);
    if constexpr (SP2) {
        PG8_STAGE(PG8_SB(0, 0), cB, voffB); PG8_STAGE(PG8_SB(0, 1), cB + hstepB, voffB); PG8_STAGE(PG8_SA(0, 0), cA, voffA); PG8_STAGE(PG8_SA(0, 1), cA + hstepA, voffA);
        if (wr == 1) PG8_BAR;
        PG8_WAIT_V(2); PG8_BAR;
        PG8_STAGE(PG8_SB(1, 0), cB + kstep, voffB); PG8_STAGE(PG8_SA(1, 0), cA + kstep, voffA); PG8_STAGE(PG8_SB(1, 1), cB + hstepB + kstep, voffB);
        PG8_WAIT_V(6); PG8_BAR;
    } else {
        PG8_STAGE(PG8_SB(0, 0), cB, voffB); PG8_STAGE(PG8_SA(0, 0), cA, voffA); PG8_STAGE(PG8_SB(0, 1), cB + hstepB, voffB); PG8_STAGE(PG8_SA(0, 1), cA + hstepA, voffA);
        if (wr == 1) PG8_BAR;
        PG8_WAIT_V(4); PG8_BAR;
        PG8_STAGE(PG8_SB(1, 0), cB + kstep, voffB); PG8_STAGE(PG8_SA(1, 0), cA + kstep, voffA); PG8_STAGE(PG8_SB(1, 1), cB + hstepB + kstep, voffB);
        PG8_WAIT_V(6); PG8_BAR;
    }
    for (;;) {
        const bool has_next = S.next(ui + 1, nxt);
        const char* nA = has_next ? (const char*)g.A + (size_t)nxt.pm * tstepA : cA; const char* nB = has_next ? (const char*)g.Bt + (size_t)nxt.pn * tstepB : cB;
        for (int t = 0; t < nt; t += 2) {
            const bool last = (t == nt - 2);
            const char* a1 = cA + (size_t)(t + 1) * kstep;
            const char* a2 = last ? nA : cA + (size_t)(t + 2) * kstep; const char* b2 = last ? nB : cB + (size_t)(t + 2) * kstep;
            const char* a3 = a2 + kstep; const char* b3 = b2 + kstep;
            if (last && has_next) S.a_ready(nxt);
            if constexpr (SP2) {
            PG8_LDB(B0, 0, 0); PG8_LDB(B1, 0, 1); PG8_SCHED; PG8_LDA(At, 0, 0); PG8_STAGE(PG8_SA(1, 1), a1 + hstepA, voffA);
            PG8_WAIT_V(8); PG8_WAIT_L(0); PG8_BAR; PG8_MMA(0, 0, At, B0); PG8_MMA(0, 1, At, B1); PG8_BAR; PG8_SCHED;
            PG8_LDA(At, 0, 1); PG8_STAGE(PG8_SB(0, 0), b2, voffB); PG8_STAGE(PG8_SB(0, 1), b2 + hstepB, voffB); PG8_STAGE(PG8_SA(0, 0), a2, voffA);
            PG8_WAIT_V(8); PG8_WAIT_L(0); PG8_BAR; PG8_MMA(1, 0, At, B0); PG8_MMA(1, 1, At, B1); PG8_BAR; PG8_SCHED;
            PG8_LDB(B0, 1, 0); PG8_LDB(B1, 1, 1); PG8_SCHED; PG8_LDA(At, 1, 0); PG8_STAGE(PG8_SA(0, 1), a2 + hstepA, voffA);
            PG8_WAIT_V(8); PG8_WAIT_L(0); PG8_BAR; PG8_MMA(0, 0, At, B0); PG8_MMA(0, 1, At, B1); PG8_BAR; PG8_SCHED;
            PG8_LDA(At, 1, 1); PG8_STAGE(PG8_SB(1, 0), b3, voffB); PG8_STAGE(PG8_SB(1, 1), b3 + hstepB, voffB); PG8_STAGE(PG8_SA(1, 0), a3, voffA);
            PG8_WAIT_V(8); PG8_WAIT_L(0); PG8_BAR; PG8_MMA(1, 0, At, B0); PG8_MMA(1, 1, At, B1); PG8_BAR; PG8_SCHED;
            } else {
            PG8_LDB(B0, 0, 0); PG8_SCHED; PG8_LDA(At, 0, 0); PG8_STAGE(PG8_SA(1, 1), a1 + hstepA, voffA);
            PG8_WAIT_L(8); PG8_BAR; PG8_WAIT_L(0); PG8_MMA(0, 0, At, B0); PG8_BAR; PG8_SCHED;
            PG8_LDB(B1, 0, 1); PG8_STAGE(PG8_SB(0, 0), b2, voffB);
            PG8_BAR; PG8_WAIT_L(0); PG8_MMA(0, 1, At, B1); PG8_BAR;
            PG8_LDA(At, 0, 1); PG8_STAGE(PG8_SA(0, 0), a2, voffA);
            PG8_BAR; PG8_WAIT_L(0); PG8_MMA(1, 0, At, B0); PG8_BAR; PG8_SCHED;
            PG8_STAGE(PG8_SB(0, 1), b2 + hstepB, voffB);
            PG8_WAIT_V(6); PG8_BAR; PG8_MMA(1, 1, At, B1); PG8_BAR;
            PG8_LDB(B0, 1, 0); PG8_SCHED; PG8_LDA(At, 1, 0); PG8_STAGE(PG8_SA(0, 1), a2 + hstepA, voffA);
            PG8_WAIT_L(8); PG8_BAR; PG8_WAIT_L(0); PG8_MMA(0, 0, At, B0); PG8_BAR; PG8_SCHED;
            PG8_LDB(B1, 1, 1); PG8_STAGE(PG8_SB(1, 0), b3, voffB);
            PG8_BAR; PG8_WAIT_L(0); PG8_MMA(0, 1, At, B1); PG8_BAR;
            PG8_LDA(At, 1, 1); PG8_STAGE(PG8_SA(1, 0), a3, voffA);
            PG8_BAR; PG8_WAIT_L(0); PG8_MMA(1, 0, At, B0); PG8_BAR; PG8_SCHED;
            PG8_STAGE(PG8_SB(1, 1), b3 + hstepB, voffB);
            PG8_WAIT_V(6); PG8_BAR; PG8_MMA(1, 1, At, B1); PG8_BAR;
            }
        }
        if constexpr (ALIGN_EPI) { if (wr == 0) PG8_BAR; }
        if constexpr (!Epi::AFTER_DRAIN) { E(acc, cur, wr, wc, fr, fq); S.done(cur); }
        if (!has_next) break;
#pragma unroll
        for (int a = 0; a < 2; ++a)
#pragma unroll
            for (int b = 0; b < 2; ++b)
#pragma unroll
                for (int m = 0; m < 4; ++m)
#pragma unroll
                    for (int n = 0; n < 2; ++n) acc[a][b][m][n] = (f32x4){0.f, 0.f, 0.f, 0.f};
        cur = nxt; cA = nA; cB = nB; ++ui;
        if constexpr (ALIGN_EPI) { if (wr == 1) PG8_BAR; }
    }
    PG8_WAIT_V(0);
    if constexpr (!ALIGN_EPI) { if (wr == 0) PG8_BAR; }
    PG8_BAR;
    if constexpr (Epi::AFTER_DRAIN) { E.fused(acc, cur, wr, wc, fr, fq, lds, wid, lane); S.done(cur); }
#undef PG8_SA
#undef PG8_SB
#undef PG8_STAGE
#undef PG8_LDA
#undef PG8_LDB
#undef PG8_MMA
#undef PG8_WAIT_V
#undef PG8_WAIT_L
#undef PG8_BAR
#undef PG8_SCHED
}
}

#define LAS __attribute__((address_space(3)))
constexpr int NWAVES = 8, NTHREADS = 512;
constexpr int LDS_BYTES = 147456;

struct Args { const float* in[N_IN]; float* out; unsigned char* ws; int ph_lo, ph_hi; };

__device__ __forceinline__ void transpose_item(const float* W, int N, bf16_t* WT, int ldt, int dst_row0, LAS float* scr, int k0, int n0, int lane) {
#pragma unroll 8
    for (int i = 0; i < 32; ++i) { const int kk = 2 * i + (lane >> 5); scr[kk * 33 + (lane & 31)] = W[(size_t)(k0 + kk) * N + n0 + (lane & 31)]; }
    asm volatile("s_waitcnt lgkmcnt(0)" ::: "memory");
    const int c = lane & 7;
#pragma unroll
    for (int j = 0; j < 4; ++j) { const int n = (lane >> 3) + 8 * j; const LAS float* s = scr + (8 * c) * 33 + n;
        pg8::u32x4 o; o.x = pg8::cvt_pk_bf16(s[0 * 33], s[1 * 33]); o.y = pg8::cvt_pk_bf16(s[2 * 33], s[3 * 33]); o.z = pg8::cvt_pk_bf16(s[4 * 33], s[5 * 33]); o.w = pg8::cvt_pk_bf16(s[6 * 33], s[7 * 33]);
        *(pg8::u32x4*)(WT + (size_t)(dst_row0 + n) * ldt + k0 + 8 * c) = o; }
    asm volatile("s_waitcnt lgkmcnt(0)" ::: "memory");
}


struct S5Par { const float *lr, *li, *ldt, *br, *bi, *cr, *ci; };
__device__ __forceinline__ void p0_s5_tables(const Args& a, LAS unsigned char* lds, int g, int dir, int tid) {
    const S5Par p = dir ? S5Par{a.in[I_LRB], a.in[I_LIB], a.in[I_LDTB], a.in[I_BRB], a.in[I_BIB], a.in[I_CRB], a.in[I_CIB]}
                        : S5Par{a.in[I_LRF], a.in[I_LIF], a.in[I_LDTF], a.in[I_BRF], a.in[I_BIF], a.in[I_CRF], a.in[I_CIF]};
    typedef float f32x2 __attribute__((ext_vector_type(2)));
    LAS f32x2* AP = (LAS f32x2*)lds;
    LAS f32x2* BB = (LAS f32x2*)(lds + 33 * 64 * 8);
    LAS f32x2* CC = (LAS f32x2*)(lds + 33 * 64 * 8 + 1024 * 8);
    const double dt = (double)expf(p.ldt[g]);
    for (int idx = tid; idx < 33 * 64; idx += NTHREADS) { const int t = idx >> 6, n = idx & 63;
        const double lr = (double)p.lr[g * SN + n], li = (double)p.li[g * SN + n];
        const double ang = (double)t * dt * li; const float rf = (float)(ang - rint(ang * 0.15915494309189535) * 6.283185307179586);
        const float mag = expf((float)((double)t * dt * lr));
        AP[idx] = (f32x2){mag * cosf(rf), mag * sinf(rf)}; }
    for (int idx = tid; idx < 64 * 16; idx += NTHREADS) { const int n = idx >> 4;
        const double lr = (double)p.lr[g * SN + n], li = (double)p.li[g * SN + n];
        const double ang = dt * li; const float rf = (float)(ang - rint(ang * 0.15915494309189535) * 6.283185307179586);
        const double mag = (double)expf((float)(dt * lr)), ar = mag * (double)cosf(rf), ai = mag * (double)sinf(rf), den = lr * lr + li * li;
        const double zr = ((ar - 1.0) * lr + ai * li) / den, zi = (ai * lr - (ar - 1.0) * li) / den;
        const double br = (double)p.br[(size_t)g * SN * 16 + idx], bi = (double)p.bi[(size_t)g * SN * 16 + idx];
        BB[idx] = (f32x2){(float)(zr * br - zi * bi), (float)(zr * bi + zi * br)}; }
    for (int idx = tid; idx < 16 * 64; idx += NTHREADS) CC[idx] = (f32x2){p.cr[(size_t)g * 1024 + idx], p.ci[(size_t)g * 1024 + idx]};
    __syncthreads();
    float* KC = (float*)(a.ws + WS_KC) + (size_t)(g * 2 + dir) * 32 * 256;
    { const int pair = tid & 255, c = pair >> 4, cp = pair & 15, t0 = (tid >> 8) * 16;
        float sacc[16];
#pragma unroll
        for (int tt = 0; tt < 16; ++tt) sacc[tt] = 0.f;
#pragma unroll 2
        for (int n = 0; n < 64; ++n) { const f32x2 cc = CC[c * 64 + n], bb = BB[n * 16 + cp], a1 = AP[64 + n], p0 = AP[t0 * 64 + n];
            const float qr = cc.x * bb.x - cc.y * bb.y, qi = cc.x * bb.y + cc.y * bb.x;
            float wr = qr * p0.x - qi * p0.y, wi = qr * p0.y + qi * p0.x;
#pragma unroll
            for (int tt = 0; tt < 16; ++tt) { sacc[tt] += wr; const float nr = wr * a1.x - wi * a1.y, ni = wr * a1.y + wi * a1.x; wr = nr; wi = ni; } }
#pragma unroll
        for (int tt = 0; tt < 16; ++tt) KC[(t0 + tt) * 256 + pair] = sacc[tt]; }
    bf16_t* BtE = (bf16_t*)(a.ws + WS_BTE) + ((size_t)g * 256 + dir * 128) * 512;
    for (int idx = tid; idx < 128 * 64; idx += NTHREADS) { const int cl = idx >> 6, k8 = idx & 63, q = cl >> 6, n = cl & 63, j = k8 >> 1, cp0 = (k8 & 1) * 8;
        const f32x2 ap = AP[(dir ? j : 31 - j) * 64 + n]; float v[8];
#pragma unroll
        for (int e = 0; e < 8; ++e) { const f32x2 bb = BB[n * 16 + cp0 + e]; v[e] = q ? (ap.x * bb.y + ap.y * bb.x) : (ap.x * bb.x - ap.y * bb.y); }
        pg8::u32x4 o; o.x = pg8::cvt_pk_bf16(v[0], v[1]); o.y = pg8::cvt_pk_bf16(v[2], v[3]); o.z = pg8::cvt_pk_bf16(v[4], v[5]); o.w = pg8::cvt_pk_bf16(v[6], v[7]);
        *(pg8::u32x4*)(BtE + (size_t)cl * 512 + k8 * 8) = o; }
    bf16_t* BtY = (bf16_t*)(a.ws + WS_BTY) + (size_t)g * 512 * 768 + 512 + dir * 128;
    for (int idx = tid; idx < 512 * 16; idx += NTHREADS) { const int rn = idx >> 4, k8 = idx & 15, q = k8 >> 3, n0 = (k8 & 7) * 8, i = rn >> 4, c = rn & 15; const int e = dir ? 32 - i : i + 1; float v[8];
#pragma unroll
        for (int x = 0; x < 8; ++x) { const f32x2 cc = CC[c * 64 + n0 + x], ap = AP[e * 64 + n0 + x]; v[x] = q ? -(cc.x * ap.y + cc.y * ap.x) : (cc.x * ap.x - cc.y * ap.y); }
        pg8::u32x4 o; o.x = pg8::cvt_pk_bf16(v[0], v[1]); o.y = pg8::cvt_pk_bf16(v[2], v[3]); o.z = pg8::cvt_pk_bf16(v[4], v[5]); o.w = pg8::cvt_pk_bf16(v[6], v[7]);
        *(pg8::u32x4*)(BtY + (size_t)rn * 768 + k8 * 8) = o; }
    if (tid < 64) ((f32x2*)(a.ws + WS_AT))[(g * 2 + dir) * 64 + tid] = AP[32 * 64 + tid];
    __syncthreads();
}

__device__ __forceinline__ void p0_prologue(const Args& a, LAS unsigned char* lds, int bx, int tid, int G, int wave, int lane) {
    unsigned char* ws = a.ws;
    if (bx < 2 * NG) { p0_s5_tables(a, lds, bx >> 1, bx & 1, tid); return; }
    const int gw = (bx - 2 * NG) * NWAVES + wave, NGW = (G - 2 * NG) * NWAVES;
    LAS float* scr = (LAS float*)(lds + wave * 16384);
    constexpr int I_IN = (D / 64) * (INW / 32), I_GLU = (SW / 64) * (SW / 32), I_OUT = (D / 64) * (D / 32), I_FI = (D / 64) * (2 * FH / 32), I_FO = (FH / 64) * (D / 32);
    constexpr int NITEMS = I_IN + I_GLU + I_OUT + I_FI + I_FO;
    for (int it = gw; it < NITEMS; it += NGW) {
        int r = it;
        if (r < I_IN) { const int nb = INW / 32; transpose_item(a.in[I_WIN], INW, (bf16_t*)(ws + WS_WIN), D, 32 * (r % nb), scr, 64 * (r / nb), 32 * (r % nb), lane); continue; } r -= I_IN;
        if (r < I_GLU) { const int nb = SW / 32; transpose_item(a.in[I_WGLU], SW, (bf16_t*)(ws + WS_WGLU), SW, 32 * (r % nb), scr, 64 * (r / nb), 32 * (r % nb), lane); continue; } r -= I_GLU;
        if (r < I_OUT) { const int nb = D / 32; transpose_item(a.in[I_WOUT], D, (bf16_t*)(ws + WS_WOUT), D, 32 * (r % nb), scr, 64 * (r / nb), 32 * (r % nb), lane); continue; } r -= I_OUT;
        if (r < I_FI) { const int nb = 2 * FH / 32; const int n0 = 32 * (r % nb); const int half = n0 >= FH ? 1 : 0; const int nn = n0 - half * FH;
            transpose_item(a.in[I_WFFNIN], 2 * FH, (bf16_t*)(ws + WS_WFI), D, (nn >> 7) * 256 + half * 128 + (nn & 127), scr, 64 * (r / nb), n0, lane); continue; } r -= I_FI;
        { const int nb = D / 32; transpose_item(a.in[I_WFFNOUT], D, (bf16_t*)(ws + WS_WFO), FH, 32 * (r % nb), scr, 64 * (r / nb), 32 * (r % nb), lane); }
    }
    float* MOD = (float*)(ws + WS_MOD);
    for (int it = NGW - 1 - gw; it < 24 * 16; it += NGW) {
        const int cg_ = it % 24, kc = it / 24; const int col = cg_ * 256 + lane * 4;
#pragma unroll
        for (int r = 0; r < 9; ++r) { const float cv = r < 8 ? a.in[I_C][r * D + kc * 64 + lane] : a.in[I_CCTX][kc * 64 + lane]; scr[r * 64 + lane] = silu_f(cv); }
        asm volatile("s_waitcnt lgkmcnt(0)" ::: "memory");
        pg8::f32x4 acc[9];
#pragma unroll
        for (int r = 0; r < 9; ++r) acc[r] = (pg8::f32x4){0.f, 0.f, 0.f, 0.f};
        if (kc == 0) { const pg8::f32x4 bb = *(const pg8::f32x4*)(a.in[I_BMOD] + col);
#pragma unroll
            for (int r = 0; r < 9; ++r) acc[r] = bb; }
#pragma unroll 4
        for (int k = 0; k < 64; ++k) {
            const pg8::f32x4 w = *(const pg8::f32x4*)(a.in[I_WMOD] + (size_t)(kc * 64 + k) * 6 * D + col);
#pragma unroll
            for (int r = 0; r < 9; ++r) acc[r] += w * scr[r * 64 + k];
        }
#pragma unroll
        for (int r = 0; r < 9; ++r)
#pragma unroll
            for (int j = 0; j < 4; ++j) atomicAdd(MOD + r * 6 * D + col + j, acc[r][j]);
        asm volatile("s_waitcnt lgkmcnt(0)" ::: "memory");
    }
    if (bx == G - 1) { float* ROPE = (float*)(ws + WS_ROPE);
        for (int e = tid; e < 64 * 32; e += NTHREADS) { const int pos = e >> 5, f = e & 31; const float inv = powf(10000.0f, -(float)f / 32.0f); const float ang = (float)pos * inv;
            ROPE[2 * e] = cosf(ang); ROPE[2 * e + 1] = sinf(ang); } }
}

__device__ __forceinline__ void p1_norm1(const Args& a, int gw, int NGW, int lane) {
    const float* MOD = (const float*)(a.ws + WS_MOD); bf16_t* H = (bf16_t*)(a.ws + WS_H); const float* g = a.in[I_GPREMIX];
    for (int row = gw; row < MT; row += NGW) {
        const float* xr; int mr;
        if (row < ML) { xr = a.in[I_X] + (size_t)row * D; mr = row >> 11; } else { xr = a.in[I_CTX] + (size_t)(row - ML) * D; mr = 8; }
        pg8::f32x4 v[4]; float s = 0.f;
#pragma unroll
        for (int j = 0; j < 4; ++j) { v[j] = *(const pg8::f32x4*)(xr + 4 * lane + 256 * j); s += (v[j][0] * v[j][0] + v[j][1] * v[j][1]) + (v[j][2] * v[j][2] + v[j][3] * v[j][3]); }
        s = wave_sum(s); const float rstd = 1.0f / sqrtf(s * (1.0f / D) + EPS);
        const float* sh = MOD + mr * 6 * D, * sc = sh + D;
#pragma unroll
        for (int j = 0; j < 4; ++j) { const int k = 4 * lane + 256 * j;
            const pg8::f32x4 gg = *(const pg8::f32x4*)(g + k), s1 = *(const pg8::f32x4*)(sc + k), s0 = *(const pg8::f32x4*)(sh + k);
            const pg8::f32x4 o = v[j] * rstd * gg * (s1 + 1.0f) + s0;
            unsigned long long w = (unsigned long long)pg8::cvt_pk_bf16(o[0], o[1]) | ((unsigned long long)pg8::cvt_pk_bf16(o[2], o[3]) << 32);
            *(unsigned long long*)(H + (size_t)row * D + k) = w; }
    }
}

__device__ __forceinline__ void p1_s5_toeplitz(const Args& a, int gtid, int NT) {
    const float* KC = (const float*)(a.ws + WS_KC); bf16_t* BtY = (bf16_t*)(a.ws + WS_BTY); const float* dv = a.in[I_S5D];
    for (int it = gtid; it < NG * 512 * 64; it += NT) {
        const int g = it >> 15, rn = (it >> 6) & 511, j = (it >> 1) & 31, hh = it & 1, i = rn >> 4, c = rn & 15, t = i - j;
        pg8::f32x4 v0, v1;
        if (t != 0) { const float* src = KC + ((size_t)(g * 2 + (t < 0 ? 1 : 0)) * 32 + (t < 0 ? -t : t)) * 256 + c * 16 + hh * 8; v0 = *(const pg8::f32x4*)src; v1 = *(const pg8::f32x4*)(src + 4); }
        else { const float* sf = KC + ((size_t)(g * 2) * 32) * 256 + c * 16 + hh * 8; const float* sb = KC + ((size_t)(g * 2 + 1) * 32) * 256 + c * 16 + hh * 8;
            v0 = *(const pg8::f32x4*)sf + *(const pg8::f32x4*)sb; v1 = *(const pg8::f32x4*)(sf + 4) + *(const pg8::f32x4*)(sb + 4);
            const float dd = dv[g * 16 + c]; const int cl = c - hh * 8;
#pragma unroll
            for (int e = 0; e < 4; ++e) { v0[e] += (cl == e) ? dd : 0.f; v1[e] += (cl == e + 4) ? dd : 0.f; } }
        *(pg8::u32x4*)(BtY + ((size_t)g * 512 + rn) * 768 + j * 16 + hh * 8) = pg8::pack8(v0, v1);
    }
}
__device__ __forceinline__ void p4_s5_scan(const Args& a, int gtid, int NT) {
    typedef float f32x2 __attribute__((ext_vector_type(2)));
    for (int idx = (gtid >> 9) * 128 + (gtid & 511); (gtid & 511) < 128 && idx < NG * BATCH * 2 * 64; idx += (NT >> 9) * 128) {
        const int n = idx & 63, dir = (idx >> 6) & 1, b = (idx >> 7) & 7, g = idx >> 10;
        const f32x2 aT = ((const f32x2*)(a.ws + WS_AT))[(g * 2 + dir) * 64 + n];
        const float* E = (const float*)(a.ws + WS_E) + (size_t)g * 768 * 256 + dir * 128 + n;
        bf16_t* Hs = (bf16_t*)(a.ws + WS_UA) + (size_t)g * 768 * 768 + 512 + dir * 128 + n;
        float hr = 0.f, hi = 0.f;
#pragma unroll
        for (int kk = 0; kk < 8; ++kk) { const int k = dir ? 7 - kk : kk; const float* e = E + (size_t)(512 + b * 8 + k) * 256; const float er = e[0], ei = e[64];
            const float nr = aT.x * hr - aT.y * hi + er, ni = aT.x * hi + aT.y * hr + ei; hr = nr; hi = ni; }
#pragma unroll 8
        for (int kk = 0; kk < 64; ++kk) { const int k = dir ? 63 - kk : kk; const int row = b * 64 + k; const float* e = E + (size_t)row * 256; const float er = e[0], ei = e[64];
            Hs[(size_t)row * 768] = f2bf(hr); Hs[(size_t)row * 768 + 64] = f2bf(hi);
            const float nr = aT.x * hr - aT.y * hi + er, ni = aT.x * hi + aT.y * hr + ei; hr = nr; hi = ni; }
    }
}

constexpr int PS_ = 132, PR_ = 136;
constexpr float LOG2E = 1.4426950408889634f;
typedef unsigned long long u64_t;
__device__ __forceinline__ pg8::bf16x8 lds_strided8(const LAS unsigned short* p, int s) {
    pg8::bf16x8 r;
#pragma unroll
    for (int jj = 0; jj < 8; ++jj) r[jj] = (short)p[(32 * s + (jj & 3) + 16 * (jj >> 2)) * PS_];
    return r;
}
__device__ __forceinline__ pg8::u32x4 scale8(const pg8::u32x4 v, float w) {
    pg8::u32x4 o;
    o.x = pg8::cvt_pk_bf16(pg8::bflo(v.x) * w, pg8::bfhi(v.x) * w); o.y = pg8::cvt_pk_bf16(pg8::bflo(v.y) * w, pg8::bfhi(v.y) * w);
    o.z = pg8::cvt_pk_bf16(pg8::bflo(v.z) * w, pg8::bfhi(v.z) * w); o.w = pg8::cvt_pk_bf16(pg8::bflo(v.w) * w, pg8::bfhi(v.w) * w);
    return o;
}
__device__ __forceinline__ void lds_w16(LAS unsigned short* p, const pg8::u32x4 v) {
    *(LAS u64_t*)p = (u64_t)v.x | ((u64_t)v.y << 32); *(LAS u64_t*)(p + 4) = (u64_t)v.z | ((u64_t)v.w << 32);
}
__device__ __forceinline__ void r1_unit(const Args& a, LAS unsigned char* lds, int unit, int tid, int wave, int lane) {
    asm volatile("" : "+v"(tid), "+v"(lane));
    const int ck = unit % 18, bh = unit / 18, b = bh >> 2, h = bh & 3;
    const size_t row0 = ck < 2 ? (size_t)ML + b * CTX + ck * 128 : (size_t)b * SEQ + (ck - 2) * 128;
    const bf16_t* QKVG = (const bf16_t*)(a.ws + WS_QKVG);
    LAS unsigned short* Kimg = (LAS unsigned short*)lds; LAS unsigned short* Vf = Kimg + 128 * PS_; LAS unsigned short* Vb = Vf + 128 * PS_;
    const float lf2 = -expf(a.in[I_DECF][h]) * LOG2E, lb2 = -expf(a.in[I_DECB][h]) * LOG2E;
#pragma unroll
    for (int it = 0; it < 4; ++it) { const int p = tid + it * NTHREADS; const int c = p >> 4, c16 = p & 15;
        const bf16_t* src = QKVG + (row0 + c) * 2048 + h * DH + c16 * 8;
        const pg8::u32x4 kk = *(const pg8::u32x4*)(src + 512), vv = *(const pg8::u32x4*)(src + 1024);
        lds_w16(Kimg + c * PS_ + c16 * 8, kk);
        lds_w16(Vf + c * PS_ + c16 * 8, scale8(vv, __builtin_amdgcn_exp2f(lf2 * (float)(127 - c))));
        lds_w16(Vb + c * PS_ + c16 * 8, scale8(vv, __builtin_amdgcn_exp2f(lb2 * (float)c))); }
    __syncthreads();
    const int dir = wave >> 2, eb = (wave & 3) * 32, fr = lane & 15, g = lane >> 4;
    const LAS unsigned short* Vd = dir ? Vb : Vf;
    pg8::f32x4 acc[8][2];
#pragma unroll
    for (int dt = 0; dt < 8; ++dt) { acc[dt][0] = (pg8::f32x4){0.f, 0.f, 0.f, 0.f}; acc[dt][1] = (pg8::f32x4){0.f, 0.f, 0.f, 0.f}; }
#pragma unroll
    for (int ks = 0; ks < 4; ++ks) {
        const pg8::bf16x8 b0 = lds_strided8(Vd + 4 * g * PS_ + eb + fr, ks), b1 = lds_strided8(Vd + 4 * g * PS_ + eb + 16 + fr, ks);
#pragma unroll
        for (int dt = 0; dt < 8; ++dt) { const pg8::bf16x8 af = lds_strided8(Kimg + 4 * g * PS_ + 16 * dt + fr, ks);
            acc[dt][0] = __builtin_amdgcn_mfma_f32_16x16x32_bf16(af, b0, acc[dt][0], 0, 0, 0);
            acc[dt][1] = __builtin_amdgcn_mfma_f32_16x16x32_bf16(af, b1, acc[dt][1], 0, 0, 0); }
    }
    bf16_t* KV = (bf16_t*)a.out + ((size_t)(bh * 2 + dir) * 18 + ck) * 16384;
#pragma unroll
    for (int dt = 0; dt < 8; ++dt)
#pragma unroll
        for (int et = 0; et < 2; ++et) { const int e = eb + 16 * et + fr, d0 = 16 * dt + 4 * g; const pg8::f32x4 v = acc[dt][et];
            *(u64_t*)(KV + e * 128 + d0) = (u64_t)pg8::cvt_pk_bf16(v[0], v[1]) | ((u64_t)pg8::cvt_pk_bf16(v[2], v[3]) << 32); }
    __syncthreads();
}
__device__ __forceinline__ void r2_scan(const Args& a, int gtid, int NT) {
    const bf16_t* KVb = (const bf16_t*)a.out; bf16_t* Sb = (bf16_t*)(a.ws + WS_H);
    for (int it = gtid; it < 64 * 2048; it += NT) {
        const int bhd = it >> 11, v8 = it & 2047, dir = bhd & 1, h = (bhd >> 1) & 3;
        const float dc = __builtin_amdgcn_exp2f(-expf(a.in[dir ? I_DECB : I_DECF][h]) * LOG2E * 128.0f);
        const bf16_t* kv = KVb + (size_t)bhd * 18 * 16384 + v8 * 8; bf16_t* S = Sb + (size_t)bhd * 16 * 16384 + v8 * 8;
        float s[8];
#pragma unroll
        for (int j = 0; j < 8; ++j) s[j] = 0.f;
#define R2_STEP(ckk) do { const pg8::u32x4 w = *(const pg8::u32x4*)(kv + (size_t)(ckk) * 16384); \
        s[0] = dc * s[0] + pg8::bflo(w.x); s[1] = dc * s[1] + pg8::bfhi(w.x); s[2] = dc * s[2] + pg8::bflo(w.y); s[3] = dc * s[3] + pg8::bfhi(w.y); \
        s[4] = dc * s[4] + pg8::bflo(w.z); s[5] = dc * s[5] + pg8::bfhi(w.z); s[6] = dc * s[6] + pg8::bflo(w.w); s[7] = dc * s[7] + pg8::bfhi(w.w); } while (0)
#define R2_OUT(n) do { pg8::u32x4 o; o.x = pg8::cvt_pk_bf16(s[0], s[1]); o.y = pg8::cvt_pk_bf16(s[2], s[3]); o.z = pg8::cvt_pk_bf16(s[4], s[5]); o.w = pg8::cvt_pk_bf16(s[6], s[7]); \
        *(pg8::u32x4*)(S + (size_t)(n) * 16384) = o; } while (0)
        if (dir == 0) { R2_STEP(0); R2_STEP(1);
#pragma unroll
            for (int n = 0; n < 16; ++n) { R2_OUT(n); R2_STEP(2 + n); } }
        else { R2_STEP(1); R2_STEP(0);
#pragma unroll
            for (int n = 15; n >= 0; --n) { R2_OUT(n); R2_STEP(2 + n); } }
#undef R2_STEP
#undef R2_OUT
    }
}
__device__ __forceinline__ void r3_unit(const Args& a, LAS unsigned char* lds, int unit, int tid, int wave, int lane) {
    asm volatile("" : "+v"(tid), "+v"(lane));
    const int n = unit & 15, bh = unit >> 4, b = bh >> 2, h = bh & 3;
    const size_t row0 = (size_t)b * SEQ + n * 128;
    const bf16_t* QKVG = (const bf16_t*)(a.ws + WS_QKVG); const bf16_t* Sb = (const bf16_t*)(a.ws + WS_H);
    LAS unsigned short* Kimg = (LAS unsigned short*)lds;
    LAS unsigned short* Vimg = Kimg + 128 * PR_;
    LAS unsigned short* SFimg = Vimg + 128 * PS_;
    LAS unsigned short* SBimg = SFimg + 128 * PR_;
    const float lf2 = -expf(a.in[I_DECF][h]) * LOG2E, lb2 = -expf(a.in[I_DECB][h]) * LOG2E;
    const bf16_t* SF = Sb + ((size_t)(bh * 2 + 0) * 16 + n) * 16384; const bf16_t* SB = Sb + ((size_t)(bh * 2 + 1) * 16 + n) * 16384;
#pragma unroll
    for (int it = 0; it < 4; ++it) { const int p = tid + it * NTHREADS; const int c = p >> 4, c16 = p & 15;
        const bf16_t* src = QKVG + (row0 + c) * 2048 + h * DH + c16 * 8;
        *(LAS pg8::u32x4*)(Kimg + c * PR_ + c16 * 8) = *(const pg8::u32x4*)(src + 512);
        lds_w16(Vimg + c * PS_ + c16 * 8, *(const pg8::u32x4*)(src + 1024));
        *(LAS pg8::u32x4*)(SFimg + c * PR_ + c16 * 8) = *(const pg8::u32x4*)(SF + c * 128 + c16 * 8);
        *(LAS pg8::u32x4*)(SBimg + c * PR_ + c16 * 8) = *(const pg8::u32x4*)(SB + c * 128 + c16 * 8); }
    const int fr = lane & 15, g = lane >> 4, il = 16 * wave + fr;
    pg8::bf16x8 qf[4];
#pragma unroll
    for (int ks = 0; ks < 4; ++ks) qf[ks] = *(const pg8::bf16x8*)(QKVG + (row0 + il) * 2048 + h * DH + 32 * ks + 8 * g);
    __syncthreads();
    pg8::bf16x8 pf[4];
#pragma unroll
    for (int s = 0; s < 4; ++s) {
        pg8::f32x4 sc[2];
#pragma unroll
        for (int t2 = 0; t2 < 2; ++t2) { const int jt = 2 * s + t2; sc[t2] = (pg8::f32x4){0.f, 0.f, 0.f, 0.f};
#pragma unroll
            for (int ks = 0; ks < 4; ++ks) { const pg8::bf16x8 kf = *(const LAS pg8::bf16x8*)(Kimg + (16 * jt + fr) * PR_ + 32 * ks + 8 * g);
                sc[t2] = __builtin_amdgcn_mfma_f32_16x16x32_bf16(kf, qf[ks], sc[t2], 0, 0, 0); }
#pragma unroll
            for (int r = 0; r < 4; ++r) { const int j = 16 * jt + 4 * g + r; const int df = il - j;
                sc[t2][r] *= __builtin_amdgcn_exp2f(df >= 0 ? lf2 * (float)df : lb2 * (float)(-df)); } }
        pg8::u32x4 w; w.x = pg8::cvt_pk_bf16(sc[0][0], sc[0][1]); w.y = pg8::cvt_pk_bf16(sc[0][2], sc[0][3]); w.z = pg8::cvt_pk_bf16(sc[1][0], sc[1][1]); w.w = pg8::cvt_pk_bf16(sc[1][2], sc[1][3]);
        pf[s] = __builtin_bit_cast(pg8::bf16x8, w);
    }
    const float cf = __builtin_amdgcn_exp2f(lf2 * (float)(il + 1)), cb = __builtin_amdgcn_exp2f(lb2 * (float)(128 - il));
    pg8::f32x4 o[8];
#pragma unroll
    for (int et = 0; et < 8; ++et) {
        pg8::f32x4 ai = (pg8::f32x4){0.f, 0.f, 0.f, 0.f}, af = ai, ab = ai;
#pragma unroll
        for (int s = 0; s < 4; ++s) { const pg8::bf16x8 vf = lds_strided8(Vimg + 4 * g * PS_ + 16 * et + fr, s);
            ai = __builtin_amdgcn_mfma_f32_16x16x32_bf16(vf, pf[s], ai, 0, 0, 0); }
#pragma unroll
        for (int ks = 0; ks < 4; ++ks) { const pg8::bf16x8 sf = *(const LAS pg8::bf16x8*)(SFimg + (16 * et + fr) * PR_ + 32 * ks + 8 * g);
            const pg8::bf16x8 sb = *(const LAS pg8::bf16x8*)(SBimg + (16 * et + fr) * PR_ + 32 * ks + 8 * g);
            af = __builtin_amdgcn_mfma_f32_16x16x32_bf16(sf, qf[ks], af, 0, 0, 0);
            ab = __builtin_amdgcn_mfma_f32_16x16x32_bf16(sb, qf[ks], ab, 0, 0, 0); }
        o[et] = ai + af * cf + ab * cb;
    }
    float s1 = 0.f;
#pragma unroll
    for (int et = 0; et < 8; ++et) s1 += (o[et][0] + o[et][1]) + (o[et][2] + o[et][3]);
    s1 += __shfl_xor(s1, 16); s1 += __shfl_xor(s1, 32);
    const float mu = s1 * (1.0f / DH); float s2 = 0.f;
#pragma unroll
    for (int et = 0; et < 8; ++et) { o[et] = o[et] - mu; s2 += (o[et][0] * o[et][0] + o[et][1] * o[et][1]) + (o[et][2] * o[et][2] + o[et][3] * o[et][3]); }
    s2 += __shfl_xor(s2, 16); s2 += __shfl_xor(s2, 32);
    const float rstd = 1.0f / sqrtf(s2 * (1.0f / DH) + EPS);
    const bf16_t* gsrc = QKVG + (row0 + il) * 2048 + 1536 + h * DH + 4 * g; const float* gn = a.in[I_GN] + h * DH + 4 * g;
    bf16_t* dst = (bf16_t*)a.out + (row0 + il) * D + h * DH + 4 * g;
#pragma unroll
    for (int et = 0; et < 8; ++et) { const u64_t gw_ = *(const u64_t*)(gsrc + 16 * et); const pg8::f32x4 gg = *(const pg8::f32x4*)(gn + 16 * et);
        const unsigned glo = (unsigned)gw_, ghi = (unsigned)(gw_ >> 32);
        const float y0 = fsilu(pg8::bflo(glo)) * (o[et][0] * rstd * gg[0]), y1 = fsilu(pg8::bfhi(glo)) * (o[et][1] * rstd * gg[1]);
        const float y2 = fsilu(pg8::bflo(ghi)) * (o[et][2] * rstd * gg[2]), y3 = fsilu(pg8::bfhi(ghi)) * (o[et][3] * rstd * gg[3]);
        *(u64_t*)(dst + 16 * et) = (u64_t)pg8::cvt_pk_bf16(y0, y1) | ((u64_t)pg8::cvt_pk_bf16(y2, y3) << 32); }
    __syncthreads();
}
__device__ __forceinline__ void p8_norm2(const Args& a, int gw, int NGW, int lane) {
    const float* MOD = (const float*)(a.ws + WS_MOD); const float* Y1 = (const float*)(a.ws + WS_Y1); bf16_t* H2 = (bf16_t*)(a.ws + WS_H);
    const float* gpost = a.in[I_GPOSTMIX]; const float* gpre = a.in[I_GPREFFN];
    for (int row = gw; row < ML; row += NGW) {
        const float* md = MOD + (row >> 11) * 6 * D;
        pg8::f32x4 y[4], xv[4]; float s = 0.f;
#pragma unroll
        for (int j = 0; j < 4; ++j) { y[j] = *(const pg8::f32x4*)(Y1 + (size_t)row * D + 4 * lane + 256 * j); s += (y[j][0] * y[j][0] + y[j][1] * y[j][1]) + (y[j][2] * y[j][2] + y[j][3] * y[j][3]); }
        s = wave_sum(s); const float rs1 = 1.0f / sqrtf(s * (1.0f / D) + EPS);
        float s2 = 0.f;
#pragma unroll
        for (int j = 0; j < 4; ++j) { const int k = 4 * lane + 256 * j;
            const pg8::f32x4 xx = *(const pg8::f32x4*)(a.in[I_X] + (size_t)row * D + k), gt = *(const pg8::f32x4*)(md + 2 * D + k), gp = *(const pg8::f32x4*)(gpost + k);
            xv[j] = xx + gt * (y[j] * rs1 * gp); s2 += (xv[j][0] * xv[j][0] + xv[j][1] * xv[j][1]) + (xv[j][2] * xv[j][2] + xv[j][3] * xv[j][3]); }
        s2 = wave_sum(s2); const float rs2 = 1.0f / sqrtf(s2 * (1.0f / D) + EPS);
#pragma unroll
        for (int j = 0; j < 4; ++j) { const int k = 4 * lane + 256 * j;
            *(pg8::f32x4*)(a.out + (size_t)row * D + k) = xv[j];
            const pg8::f32x4 gg = *(const pg8::f32x4*)(gpre + k), s1 = *(const pg8::f32x4*)(md + 4 * D + k), s0 = *(const pg8::f32x4*)(md + 3 * D + k);
            const pg8::f32x4 o = xv[j] * rs2 * gg * (s1 + 1.0f) + s0;
            unsigned long long w = (unsigned long long)pg8::cvt_pk_bf16(o[0], o[1]) | ((unsigned long long)pg8::cvt_pk_bf16(o[2], o[3]) << 32);
            *(unsigned long long*)(H2 + (size_t)row * D + k) = w; }
    }
}
__device__ __forceinline__ void p11_final(const Args& a, int gw, int NGW, int lane) {
    const float* MOD = (const float*)(a.ws + WS_MOD); const float* Y2 = (const float*)(a.ws + WS_Y2); const float* gpost = a.in[I_GPOSTFFN];
    for (int row = gw; row < ML; row += NGW) {
        const float* md = MOD + (row >> 11) * 6 * D;
        pg8::f32x4 y[4]; float s = 0.f;
#pragma unroll
        for (int j = 0; j < 4; ++j) { y[j] = *(const pg8::f32x4*)(Y2 + (size_t)row * D + 4 * lane + 256 * j); s += (y[j][0] * y[j][0] + y[j][1] * y[j][1]) + (y[j][2] * y[j][2] + y[j][3] * y[j][3]); }
        s = wave_sum(s); const float rs = 1.0f / sqrtf(s * (1.0f / D) + EPS);
#pragma unroll
        for (int j = 0; j < 4; ++j) { const int k = 4 * lane + 256 * j;
            float* op = a.out + (size_t)row * D + k;
            const pg8::f32x4 x1 = *(const pg8::f32x4*)op, gt = *(const pg8::f32x4*)(md + 5 * D + k), gp = *(const pg8::f32x4*)(gpost + k);
            *(pg8::f32x4*)op = x1 + gt * (y[j] * rs * gp); }
    }
}

__global__ void __launch_bounds__(NTHREADS, 2) mk_fwd(Args a) {
    extern __shared__ __attribute__((aligned(16))) unsigned char lds_raw[];
    LAS unsigned char* lds = (LAS unsigned char*)lds_raw;
    cg::grid_group grid = cg::this_grid();
    const int tid = threadIdx.x, lane = tid & 63, wave = __builtin_amdgcn_readfirstlane(tid >> 6);
    const int G = gridDim.x, bx = blockIdx.x;
    const int gw = bx * NWAVES + wave, NGW = G * NWAVES;
    unsigned char* ws = a.ws;
    const int lo = a.ph_lo, hi = a.ph_hi;
#define IN(k) (lo <= (k) && (k) < hi)
#ifdef PROBE_LO
    unsigned long long* stamps = (unsigned long long*)(ws + 512 * 1024);
#define STAMP(i) do { if (bx == 0 && tid == 0) stamps[i] = __builtin_amdgcn_s_memrealtime(); } while (0)
#else
#define STAMP(i) do { } while (0)
#endif
#define SEAM(k) do { STAMP(2 * (k) + 1); if (IN(k) && IN((k) + 1)) grid.sync(); STAMP(2 * (k) + 2); } while (0)
    STAMP(0);

    if (IN(0)) { p0_prologue(a, lds, bx, tid, G, wave, lane); __syncthreads(); }
    SEAM(0);
    if (IN(1)) { p1_s5_toeplitz(a, bx * NTHREADS + tid, G * NTHREADS); p1_norm1(a, gw, NGW, lane); }
    SEAM(1);
    if (IN(2)) {
        pg8::Gemm g{(const bf16_t*)(ws + WS_H), (const bf16_t*)(ws + WS_WIN), D, D, D}; pg8::StaticOrder S; S.init(MT / 256, INW / 256, G, bx);
        pg8::EpiInProjM E{(bf16_t*)(ws + WS_QKVG), (bf16_t*)(ws + WS_UA), (const float*)(ws + WS_ROPE)};
        pg8::gemm_phase<pg8::EpiInProjM, pg8::StaticOrder, true, true>(lds, g, S, E);
    }
    SEAM(2);
    if (IN(3)) {
        pg8::Gemm g{(const bf16_t*)(ws + WS_UA), (const bf16_t*)(ws + WS_BTE), 768, 512, 512}; pg8::S5EOrder S{G, bx};
        pg8::EpiS5E E{(float*)(ws + WS_E)};
        pg8::gemm_phase<pg8::EpiS5E, pg8::S5EOrder, true, true>(lds, g, S, E);
        __syncthreads();
        for (int u = bx; u < 32 * 18; u += G) r1_unit(a, lds, u, tid, wave, lane);
    }
    SEAM(3);
    if (IN(4)) { p4_s5_scan(a, bx * NTHREADS + tid, G * NTHREADS); r2_scan(a, bx * NTHREADS + tid, G * NTHREADS); }
    SEAM(4);
    if (IN(5)) {
        pg8::Gemm g{(const bf16_t*)(ws + WS_UA), (const bf16_t*)(ws + WS_BTY), 768, 768, 768}; pg8::S5YOrder S{G, bx};
        pg8::EpiS5Y E{(bf16_t*)(ws + WS_Z)};
        pg8::gemm_phase<pg8::EpiS5Y, pg8::S5YOrder, true, true>(lds, g, S, E);
        __syncthreads();
        for (int u = bx; u < 32 * 16; u += G) r3_unit(a, lds, u, tid, wave, lane);
    }
    SEAM(5);
    if (IN(6)) {
        pg8::Gemm g{(const bf16_t*)(ws + WS_Z), (const bf16_t*)(ws + WS_WGLU), SW, SW, SW}; pg8::StaticOrder S; S.init(ML / 256, SW / 256, G, bx);
        pg8::EpiGluM E{(const bf16_t*)(ws + WS_Z), a.in[I_BGLU], (bf16_t*)a.out};
        pg8::gemm_phase<pg8::EpiGluM, pg8::StaticOrder, true, true>(lds, g, S, E);
    }
    SEAM(6);
    if (IN(7)) {
        pg8::Gemm g{(const bf16_t*)a.out, (const bf16_t*)(ws + WS_WOUT), D, D, D}; pg8::StaticOrder S; S.init(ML / 256, D / 256, G, bx);
        pg8::EpiF32M E{(float*)(ws + WS_Y1), D};
        pg8::gemm_phase<pg8::EpiF32M, pg8::StaticOrder, true, true>(lds, g, S, E);
    }
    SEAM(7);
    if (IN(8)) { p8_norm2(a, gw, NGW, lane); }
    SEAM(8);
    if (IN(9)) {
        pg8::Gemm g{(const bf16_t*)(ws + WS_H), (const bf16_t*)(ws + WS_WFI), D, D, D}; pg8::StaticOrder S; S.init(ML / 256, 2 * FH / 256, G, bx);
        pg8::EpiSwigluM E{(bf16_t*)(ws + WS_HID)};
        pg8::gemm_phase<pg8::EpiSwigluM, pg8::StaticOrder, true, true>(lds, g, S, E);
    }
    SEAM(9);
    if (IN(10)) {
        pg8::Gemm g{(const bf16_t*)(ws + WS_HID), (const bf16_t*)(ws + WS_WFO), FH, FH, FH}; pg8::StaticOrder S; S.init(ML / 256, D / 256, G, bx);
        pg8::EpiF32M E{(float*)(ws + WS_Y2), D};
        pg8::gemm_phase<pg8::EpiF32M, pg8::StaticOrder, true, true>(lds, g, S, E);
    }
    SEAM(10);
    if (IN(11)) { p11_final(a, gw, NGW, lane); }
#ifdef PROBE_LO
    STAMP(23); grid.sync();
    {
#ifdef PROBE_CAL
        const unsigned long long K = PROBE_CAL;
#else
        const unsigned long long K = ((stamps[PROBE_HI] - stamps[PROBE_LO]) * PROBE_SCALE);
#endif
        for (unsigned long long e = (unsigned long long)bx * NTHREADS + tid; e < K && e < (unsigned long long)ML * D; e += (unsigned long long)G * NTHREADS) a.out[e] += 0.125f;
    }
#endif
#undef IN
#undef SEAM
}

#ifdef NAIVE_RET
__global__ __launch_bounds__(128) void k_ret_naive(const bf16_t* QKVG, const float* decf, const float* decb, const float* gn, bf16_t* MIX) {
    const int i = blockIdx.x % SEQ, h = (blockIdx.x / SEQ) % NH, b = blockIdx.x / (SEQ * NH), t = threadIdx.x;
    __shared__ float sq[128]; __shared__ float sp[SEQ + CTX]; __shared__ float red[2][2];
    const size_t row = (size_t)b * SEQ + i;
    sq[t] = bf2f(QKVG[row * 2048 + h * DH + t]);
    __syncthreads();
    const float lgf = -expf(decf[h]), lgb = -expf(decb[h]);
    for (int kk = t; kk < SEQ + CTX; kk += 128) {
        size_t krow; float w;
        if (kk < SEQ) { krow = (size_t)b * SEQ + kk; w = (kk <= i) ? expf(lgf * (float)(i - kk)) : expf(lgb * (float)(kk - i)); }
        else { const int tc = kk - SEQ; krow = (size_t)ML + b * CTX + tc; w = expf(lgf * (float)(i + CTX - tc)) + expf(lgb * (float)(SEQ + tc - i)); }
        const bf16_t* kp = QKVG + krow * 2048 + 512 + h * DH;
        float s = 0.f;
        for (int d = 0; d < DH; ++d) s += sq[d] * bf2f(kp[d]);
        sp[kk] = s * w;
    }
    __syncthreads();
    float o = 0.f;
    for (int kk = 0; kk < SEQ + CTX; ++kk) {
        const size_t krow = kk < SEQ ? (size_t)b * SEQ + kk : (size_t)ML + b * CTX + (kk - SEQ);
        o += sp[kk] * bf2f(QKVG[krow * 2048 + 1024 + h * DH + t]);
    }
    float s1 = wave_sum(o);
    if ((t & 63) == 0) red[0][t >> 6] = s1;
    __syncthreads();
    const float mu = (red[0][0] + red[0][1]) / DH;
    const float dv = o - mu;
    float s2 = wave_sum(dv * dv);
    if ((t & 63) == 0) red[1][t >> 6] = s2;
    __syncthreads();
    const float var = (red[1][0] + red[1][1]) / DH;
    const float on = dv / sqrtf(var + EPS) * gn[h * DH + t];
    const float gate = bf2f(QKVG[row * 2048 + 1536 + h * DH + t]);
    MIX[row * 1024 + h * DH + t] = f2bf(silu_f(gate) * on);
}

#endif
static void launch_phases(const Args& base, int lo, int hi, int grid, hipStream_t stream) {
    Args a = base; a.ph_lo = lo; a.ph_hi = hi;
    hipLaunchKernelGGL(mk_fwd, dim3(grid), dim3(NTHREADS), LDS_BYTES, stream, a);
}
extern "C" void kernel_launch(void* const* d_in, const int* in_sizes, int n_in, void* d_out, int out_size, void* d_ws, size_t ws_size, hipStream_t stream) {
    (void)in_sizes; (void)n_in; (void)out_size; (void)ws_size;
    static int grid = 0;
    if (grid == 0) {
        int dev = 0, cus = 0, per_cu = 0;
        (void)hipGetDevice(&dev); (void)hipDeviceGetAttribute(&cus, hipDeviceAttributeMultiprocessorCount, dev);
        (void)hipFuncSetAttribute((const void*)mk_fwd, hipFuncAttributeMaxDynamicSharedMemorySize, LDS_BYTES);
        (void)hipOccupancyMaxActiveBlocksPerMultiprocessor(&per_cu, (const void*)mk_fwd, NTHREADS, LDS_BYTES);
        if (per_cu < 1) { fprintf(stderr, "kernel_launch: occupancy query reports %d blocks/CU\n", per_cu); per_cu = 1; }
        grid = cus * (per_cu < 1 ? 1 : 1);
        (void)hipGetLastError();
    }
    Args a{};
    for (int i = 0; i < N_IN; ++i) a.in[i] = (const float*)d_in[i];
    a.out = (float*)d_out; a.ws = (unsigned char*)d_ws;
    unsigned char* ws = (unsigned char*)d_ws;
    (void)hipMemsetAsync(ws + WS_CTL, 0, CTL_ZERO_BYTES, stream);
#ifdef MK_LAUNCH_PER_PHASE
    for (int p = 0; p < 12; ++p) launch_phases(a, p, p + 1, grid, stream);
#else
    a.ph_lo = 0; a.ph_hi = 12;
    void* kargs[] = {&a};
    const hipError_t e = hipLaunchCooperativeKernel((const void*)mk_fwd, dim3(grid), dim3(NTHREADS), kargs, LDS_BYTES, stream);
    if (e != hipSuccess) fprintf(stderr, "cooperative launch failed: %s (grid %d)\n", hipGetErrorString(e), grid);
#endif
}
```
